# Optimizing an MI355X kernel written in HIP

```python
import math
import jax, jax.numpy as jnp
from jax import lax
import numpy as np

D_MODEL = 2048
BATCH = 4
SEQ = 2048
DEPTH = 2
DEC_BATCH = 128
DEC_SEQ = 8
PAST_LEN = 16384
PAGE_SIZE = 128

D_MIX = D_MODEL
D_SSM = D_MIX // 4
D_RET = D_MIX // 2
D_POOL = D_MIX - D_SSM - D_RET
SSM_GROUP = 16
SSM_GROUPS = D_SSM // SSM_GROUP
SSM_STATE = 64
RET_HEADS = 8
RET_HD = D_RET // RET_HEADS
RET_CHUNK = 128
POOL_WINDOWS = (2, 4, 8, 16)
POOL_GROUPS = len(POOL_WINDOWS)
POOL_GD = D_POOL // POOL_GROUPS
POOL_BUF = max(POOL_WINDOWS) - 1
D_FF = ((8 * D_MODEL // 3 + 127) // 128) * 128
CONV_W = 3
D_IN = D_SSM + 4 * D_RET + D_POOL
ROPE_BASE = 10000.0
EPS = 1e-6

kernel_name = 'hybrid_s5_retention_pool_adaln_decoder_step'


def rmsnorm(x, g):
    xf = x.astype(jnp.float32)
    xf = xf * lax.rsqrt(jnp.mean(xf * xf, axis=-1, keepdims=True) + EPS)
    return xf.astype(x.dtype) * g


def head_norm(o):
    mu = jnp.mean(o, axis=-1, keepdims=True)
    var = jnp.mean(jnp.square(o - mu), axis=-1, keepdims=True)
    return (o - mu) * lax.rsqrt(var + EPS)


def rotary(x, pos):
    half = x.shape[-1] // 2
    inv = ROPE_BASE ** (-jnp.arange(half, dtype=jnp.float32) / half)
    ang = pos.astype(jnp.float32)[:, None] * inv[None, :]
    cos = jnp.cos(ang)[None, :, None, :]
    sin = jnp.sin(ang)[None, :, None, :]
    xf = x.astype(jnp.float32)
    x1, x2 = xf[..., :half], xf[..., half:]
    return jnp.concatenate([x1 * cos - x2 * sin, x1 * sin + x2 * cos], axis=-1)


def _complex_affine_combine(e1, e2):
    a1r, a1i, b1r, b1i = e1
    a2r, a2i, b2r, b2i = e2
    ar = a2r * a1r - a2i * a1i
    ai = a2r * a1i + a2i * a1r
    br = a2r * b1r - a2i * b1i + b2r
    bi = a2r * b1i + a2i * b1r + b2i
    return (ar, ai, br, bi)


def s5_ssm(u, h0_re, h0_im, a_re, a_im, log_dt, b_re, b_im, c_re, c_im, d_skip):
    f32 = jnp.float32
    bsz, L, _ = u.shape
    uf = u.astype(f32)
    ug = uf.reshape(bsz, L, SSM_GROUPS, SSM_GROUP)
    lam_re, lam_im = a_re.astype(f32), a_im.astype(f32)
    dt = jnp.exp(log_dt.astype(f32))[:, None]
    mag = jnp.exp(lam_re * dt)
    ab_re, ab_im = mag * jnp.cos(lam_im * dt), mag * jnp.sin(lam_im * dt)
    den = lam_re * lam_re + lam_im * lam_im
    f_re = ((ab_re - 1.0) * lam_re + ab_im * lam_im) / den
    f_im = (ab_im * lam_re - (ab_re - 1.0) * lam_im) / den
    br, bi = b_re.astype(f32), b_im.astype(f32)
    bb_re = f_re[..., None] * br - f_im[..., None] * bi
    bb_im = f_re[..., None] * bi + f_im[..., None] * br
    drive_re = jnp.einsum('blgh,gph->blgp', ug, bb_re)
    drive_im = jnp.einsum('blgh,gph->blgp', ug, bb_im)
    a_seq_re = jnp.broadcast_to(ab_re, drive_re.shape)
    a_seq_im = jnp.broadcast_to(ab_im, drive_im.shape)
    pr, pi, hr, hi = lax.associative_scan(
        _complex_affine_combine, (a_seq_re, a_seq_im, drive_re, drive_im), axis=1)
    h0r = h0_re.astype(f32)[:, None]
    h0i = h0_im.astype(f32)[:, None]
    hr = hr + pr * h0r - pi * h0i
    hi = hi + pr * h0i + pi * h0r
    y = (jnp.einsum('blgp,ghp->blgh', hr, c_re.astype(f32))
         - jnp.einsum('blgp,ghp->blgh', hi, c_im.astype(f32)))
    y = y.reshape(bsz, L, D_SSM) + d_skip.astype(f32) * uf
    return y.astype(u.dtype), hr[:, -1], hi[:, -1]


def retention_chunkwise(q, k, v, s0):
    f32 = jnp.float32
    bsz, L, H, D = q.shape
    C = math.gcd(L, RET_CHUNK)
    n = L // C
    lg = jnp.log1p(-jnp.exp2(-5.0 - jnp.arange(H, dtype=f32)))
    idx = jnp.arange(C, dtype=f32)
    diff = idx[:, None] - idx[None, :]
    mask = jnp.where(diff[None] >= 0.0,
                     jnp.exp(jnp.maximum(diff, 0.0)[None] * lg[:, None, None]), 0.0)
    q_dec = jnp.exp((idx + 1.0)[:, None] * lg[None, :])
    k_dec = jnp.exp((C - 1.0 - idx)[:, None] * lg[None, :])
    c_dec = jnp.exp(C * lg)

    def blocks(t):
        return t.astype(f32).reshape(bsz, n, C, H, D).transpose(1, 0, 2, 3, 4)

    qb, kb, vb = blocks(q), blocks(k) * (D ** -0.5), blocks(v)

    def step(S, inp):
        qc, kc, vc = inp
        sc = jnp.einsum('bihd,bjhd->bhij', qc, kc) * mask[None]
        o = (jnp.einsum('bhij,bjhe->bihe', sc, vc)
             + jnp.einsum('bihd,bhde->bihe', qc * q_dec[None, :, :, None], S))
        S = (S * c_dec[None, :, None, None]
             + jnp.einsum('bjhd,bjhe->bhde', kc * k_dec[None, :, :, None], vc))
        return S, o

    S, ob = lax.scan(step, s0.astype(f32), (qb, kb, vb))
    return ob.transpose(1, 0, 2, 3, 4).reshape(bsz, L, H, D), S


def pool_mixer(u, buf, pos, w_pool, pool_scale):
    f32 = jnp.float32
    bsz, L, _ = u.shape
    full = jnp.concatenate([buf.astype(u.dtype), u], axis=1)
    ff = full.astype(f32)
    cs = jnp.concatenate([jnp.zeros((bsz, 1, D_POOL), f32), jnp.cumsum(ff, axis=1)], axis=1)
    end = cs[:, POOL_BUF + 1:]
    parts = []
    for gi, w in enumerate(POOL_WINDOWS):
        lo, hi = gi * POOL_GD, (gi + 1) * POOL_GD
        start = cs[:, POOL_BUF + 1 - w: POOL_BUF + 1 - w + L, lo:hi]
        cnt = jnp.minimum(pos + 1, w).astype(f32)[None, :, None]
        parts.append((end[..., lo:hi] - start) / cnt)
    pooled = jnp.concatenate(parts, axis=-1) - ff[:, POOL_BUF:]
    mixed = jnp.einsum('blgc,gcd->blgd',
                       pooled.reshape(bsz, L, POOL_GROUPS, POOL_GD).astype(u.dtype), w_pool)
    y = mixed.reshape(bsz, L, D_POOL) * pool_scale
    return y, full[:, -POOL_BUF:]


def conv_ffn(h, buf, w_up, conv_w, conv_b, w_down):
    L = h.shape[1]
    a, b = jnp.split(h @ w_up, 2, axis=-1)
    full = jnp.concatenate([buf.astype(a.dtype), a], axis=1)
    conv = conv_b + full[:, 0:L] * conv_w[0]
    for j in range(1, CONV_W):
        conv = conv + full[:, j:j + L] * conv_w[j]
    return (jax.nn.silu(conv) * b) @ w_down, full[:, -(CONV_W - 1):]


def hybrid_layer(x, c, pos0, h0_re, h0_im, s_ret, pool_buf, conv_buf,
                 w_ada, b_ada, norm1_g, w_in, a_re, a_im, log_dt, b_re, b_im, c_re, c_im, d_skip,
                 w_glu, b_glu, w_pool, pool_scale, w_out, norm2_g, w_up, conv_w, conv_b, w_down):
    bsz, L, _ = x.shape
    pos = pos0 + jnp.arange(L, dtype=jnp.int32)
    mod = jax.nn.silu(c) @ w_ada + b_ada
    sh1, sc1, g1, sh2, sc2, g2 = [m[:, None, :] for m in jnp.split(mod, 6, axis=-1)]

    h = rmsnorm(x, norm1_g) * (1.0 + sc1) + sh1
    proj = h @ w_in
    u_a, q, k, v, g, u_c = jnp.split(
        proj, [D_SSM, D_SSM + D_RET, D_SSM + 2 * D_RET, D_SSM + 3 * D_RET, D_SSM + 4 * D_RET], axis=-1)

    y_a, hT_re, hT_im = s5_ssm(u_a, h0_re, h0_im, a_re, a_im, log_dt, b_re, b_im, c_re, c_im, d_skip)
    y_a = jax.nn.gelu(y_a)
    y_a = y_a * jax.nn.sigmoid(y_a @ w_glu + b_glu)

    qr = rotary(q.reshape(bsz, L, RET_HEADS, RET_HD), pos)
    kr = rotary(k.reshape(bsz, L, RET_HEADS, RET_HD), pos)
    o, s_new = retention_chunkwise(qr, kr, v.reshape(bsz, L, RET_HEADS, RET_HD), s_ret)
    y_b = (head_norm(o).reshape(bsz, L, D_RET) * jax.nn.silu(g.astype(jnp.float32))).astype(x.dtype)

    y_c, pool_new = pool_mixer(u_c, pool_buf, pos, w_pool, pool_scale)

    x = x + g1 * (jnp.concatenate([y_a, y_b, y_c], axis=-1) @ w_out)

    h2 = rmsnorm(x, norm2_g) * (1.0 + sc2) + sh2
    f, conv_new = conv_ffn(h2, conv_buf, w_up, conv_w, conv_b, w_down)
    x = x + g2 * f
    return x, (hT_re, hT_im, s_new, pool_new, conv_new)


def setup_inputs(seed: int = 0) -> dict:
    key = jax.random.key(seed)
    ks = list(jax.random.split(key, 40))
    f32 = jnp.float32

    def nrm(shape, scale):
        return jax.random.normal(ks.pop(), shape, f32) * scale

    x_prompt = nrm((BATCH, SEQ, D_MODEL), 1.0)
    x_sample = nrm((DEC_BATCH, DEC_SEQ, D_MODEL), 1.0)
    state_ssm_re = nrm((DEPTH, DEC_BATCH, SSM_GROUPS, SSM_STATE), 0.5)
    state_ssm_im = nrm((DEPTH, DEC_BATCH, SSM_GROUPS, SSM_STATE), 0.5)
    state_ret = nrm((DEPTH, DEC_BATCH, RET_HEADS, RET_HD, RET_HD), 0.5)
    state_pool = nrm((DEPTH, DEC_BATCH, POOL_BUF, D_POOL), 1.0)
    state_ffn_conv = nrm((DEPTH, DEC_BATCH, CONV_W - 1, D_FF), 1.0)
    c_prompt = nrm((BATCH, D_MODEL), 1.0)
    c_sample = nrm((DEC_BATCH, D_MODEL), 1.0)
    w_ada = nrm((DEPTH, D_MODEL, 6 * D_MODEL), 0.5 * D_MODEL ** -0.5)
    b_ada = nrm((DEPTH, 6 * D_MODEL), 0.02)
    norm1_g = 1.0 + nrm((DEPTH, D_MODEL), 0.02)
    w_in = nrm((DEPTH, D_MODEL, D_IN), D_MODEL ** -0.5)
    ssm_a_re = -0.5 + nrm((DEPTH, SSM_GROUPS, SSM_STATE), 0.01)
    ssm_a_im = math.pi * jnp.arange(SSM_STATE, dtype=f32) + nrm((DEPTH, SSM_GROUPS, SSM_STATE), 0.01)
    ssm_log_dt = jax.random.uniform(ks.pop(), (DEPTH, SSM_GROUPS), f32, math.log(1e-3), math.log(1e-1))
    ssm_b_re = nrm((DEPTH, SSM_GROUPS, SSM_STATE, SSM_GROUP), (2 * SSM_GROUP) ** -0.5)
    ssm_b_im = nrm((DEPTH, SSM_GROUPS, SSM_STATE, SSM_GROUP), (2 * SSM_GROUP) ** -0.5)
    ssm_c_re = nrm((DEPTH, SSM_GROUPS, SSM_GROUP, SSM_STATE), SSM_STATE ** -0.5)
    ssm_c_im = nrm((DEPTH, SSM_GROUPS, SSM_GROUP, SSM_STATE), SSM_STATE ** -0.5)
    ssm_d = nrm((DEPTH, D_SSM), 1.0)
    ssm_w_glu = nrm((DEPTH, D_SSM, D_SSM), D_SSM ** -0.5)
    ssm_b_glu = nrm((DEPTH, D_SSM), 0.02)
    pool_w = nrm((DEPTH, POOL_GROUPS, POOL_GD, POOL_GD), POOL_GD ** -0.5)
    pool_scale = 1.0 + nrm((DEPTH, D_POOL), 0.02)
    w_out = nrm((DEPTH, D_MIX, D_MODEL), D_MIX ** -0.5)
    norm2_g = 1.0 + nrm((DEPTH, D_MODEL), 0.02)
    ffn_w_up = nrm((DEPTH, D_MODEL, 2 * D_FF), D_MODEL ** -0.5)
    ffn_conv_w = nrm((DEPTH, CONV_W, D_FF), CONV_W ** -0.5)
    ffn_conv_b = nrm((DEPTH, D_FF), 0.02)
    ffn_w_down = nrm((DEPTH, D_FF, D_MODEL), D_FF ** -0.5)
    final_norm_g = 1.0 + nrm((D_MODEL,), 0.02)
    return {
        'x_prompt': x_prompt, 'x_sample': x_sample,
        'state_ssm_re': state_ssm_re, 'state_ssm_im': state_ssm_im, 'state_ret': state_ret,
        'state_pool': state_pool, 'state_ffn_conv': state_ffn_conv,
        'c_prompt': c_prompt, 'c_sample': c_sample,
        'w_ada': w_ada, 'b_ada': b_ada, 'norm1_g': norm1_g, 'w_in': w_in,
        'ssm_a_re': ssm_a_re, 'ssm_a_im': ssm_a_im, 'ssm_log_dt': ssm_log_dt,
        'ssm_b_re': ssm_b_re, 'ssm_b_im': ssm_b_im, 'ssm_c_re': ssm_c_re, 'ssm_c_im': ssm_c_im,
        'ssm_d': ssm_d, 'ssm_w_glu': ssm_w_glu, 'ssm_b_glu': ssm_b_glu,
        'pool_w': pool_w, 'pool_scale': pool_scale, 'w_out': w_out, 'norm2_g': norm2_g,
        'ffn_w_up': ffn_w_up, 'ffn_conv_w': ffn_conv_w, 'ffn_conv_b': ffn_conv_b, 'ffn_w_down': ffn_w_down,
        'final_norm_g': final_norm_g,
    }


def reference(x_prompt, x_sample, state_ssm_re, state_ssm_im, state_ret, state_pool, state_ffn_conv,
              c_prompt, c_sample, w_ada, b_ada, norm1_g, w_in, ssm_a_re, ssm_a_im, ssm_log_dt,
              ssm_b_re, ssm_b_im, ssm_c_re, ssm_c_im, ssm_d, ssm_w_glu, ssm_b_glu, pool_w, pool_scale,
              w_out, norm2_g, ffn_w_up, ffn_conv_w, ffn_conv_b, ffn_w_down, final_norm_g):

    def run(x, c, pos0, st_re, st_im, st_ret, st_pool, st_conv):
        new = ([], [], [], [], [])
        for l in range(DEPTH):
            x, ns = hybrid_layer(
                x, c, pos0, st_re[l], st_im[l], st_ret[l], st_pool[l], st_conv[l],
                w_ada[l], b_ada[l], norm1_g[l], w_in[l], ssm_a_re[l], ssm_a_im[l], ssm_log_dt[l],
                ssm_b_re[l], ssm_b_im[l], ssm_c_re[l], ssm_c_im[l], ssm_d[l], ssm_w_glu[l], ssm_b_glu[l],
                pool_w[l], pool_scale[l], w_out[l], norm2_g[l], ffn_w_up[l], ffn_conv_w[l],
                ffn_conv_b[l], ffn_w_down[l])
            for lst, s in zip(new, ns):
                lst.append(s)
        return rmsnorm(x, final_norm_g), [jnp.stack(s) for s in new]

    bp = x_prompt.shape[0]
    dt = x_prompt.dtype
    y_prompt, (p_re, p_im, p_ret, p_pool, p_conv) = run(
        x_prompt, c_prompt, 0,
        jnp.zeros((DEPTH, bp, SSM_GROUPS, SSM_STATE), jnp.float32),
        jnp.zeros((DEPTH, bp, SSM_GROUPS, SSM_STATE), jnp.float32),
        jnp.zeros((DEPTH, bp, RET_HEADS, RET_HD, RET_HD), jnp.float32),
        jnp.zeros((DEPTH, bp, POOL_BUF, D_POOL), dt),
        jnp.zeros((DEPTH, bp, CONV_W - 1, D_FF), dt))
    y_sample, (s_re, s_im, s_ret, s_pool, s_conv) = run(
        x_sample, c_sample, PAST_LEN, state_ssm_re, state_ssm_im, state_ret, state_pool, state_ffn_conv)
    return (y_prompt, y_sample, p_re, p_im, p_ret, p_pool, p_conv, s_re, s_im, s_ret, s_pool, s_conv)
```

```cpp
#include <hip/hip_runtime.h>
#include <cstdio>
#include <cstdint>

#ifndef MK_PER_PHASE
#define MK_PER_PHASE 0
#endif

namespace pg8 {
#define PG8_LAS __attribute__((address_space(3)))
typedef unsigned short bf16_t;
typedef short bf16x8 __attribute__((ext_vector_type(8)));
typedef float f32x4 __attribute__((ext_vector_type(4)));
typedef unsigned u32x4 __attribute__((ext_vector_type(4)));
constexpr int BM = 256, BK = 64, HALF = 128, HTB = HALF * BK * 2, STAGE_BYTES = 8 * HTB, NXCD = 8, WGM = 8;

__host__ __device__ __forceinline__ int lds_byte(int r, int c) { const int st = (r >> 4) * 2 + (c >> 5), rr = r & 15, cc = c & 31, ob = rr * 64 + cc * 2; return st * 1024 + (ob ^ (((ob >> 9) & 1) << 5)); }
__host__ __device__ __forceinline__ void stage_rc(int b, int& R, int& C) { const int st = b / 1024, sb = b % 1024, swz = sb ^ (((sb >> 9) & 1) << 5); R = (st >> 1) * 16 + swz / 64; C = (st & 1) * 32 + (swz % 64) / 2; }
__host__ __device__ __forceinline__ int perm32(int rho) { const int n = rho >> 4, i = rho & 15; return 8 * (i >> 2) + 4 * n + (i & 3); }

struct Unit { int pm, pn, k0, nt, part; };
struct Gemm { const bf16_t* A; const bf16_t* Bt; int M, N, K; };

struct StaticOrder {
    int nM, nN, nwg, G, c, ntk;
    __host__ __device__ void init(int M, int N, int K, int G_, int c_) { nM = M / BM; nN = N / BM; nwg = nM * nN; G = G_; c = c_; ntk = K / BK; }
    __host__ __device__ bool next(int i, Unit& u) const {
        const long L = (long)i * G + c; if (L >= nwg) return false;
        int wgid = (int)L; { const int q = nwg / NXCD, r = nwg % NXCD, xcd = wgid % NXCD, off = wgid / NXCD; wgid = (xcd < r ? xcd * (q + 1) : r * (q + 1) + (xcd - r) * q) + off; }
        const int nig = WGM * nN, gid = wgid / nig, fm = gid * WGM, gsz = (nM - fm) < WGM ? (nM - fm) : WGM;
        u.pm = fm + ((wgid % nig) % gsz); u.pn = (wgid % nig) / gsz; u.k0 = 0; u.nt = ntk; u.part = -1; return true;
    }
    __device__ __forceinline__ void a_ready(const Unit&) const {}
    __device__ __forceinline__ void done(const Unit&) const {}
};
struct TailOrder {
    StaticOrder so; int c, G;
    __host__ __device__ void init(int K, int G_, int c_) { so.init(9216, 42 * 256, K, G_, c_); c = c_; G = G_; }
    __host__ __device__ bool next(int i, Unit& u) const {
        if (i < 6) { const int L = i * G + c; if (L < 1512) return so.next(i, u); u.pm = L - 1512; u.pn = 42; u.k0 = 0; u.nt = so.ntk; u.part = -1; return true; }
#ifndef TAILSPLIT
#define TAILSPLIT 0
#endif
        if (!TAILSPLIT) { if (i != 6 || c >= 12) return false; u.pm = 24 + c; u.pn = 42; u.k0 = 0; u.nt = so.ntk; u.part = -1; return true; }
        if (i != 6 || c >= 96) return false;
        u.pm = 24 + (c >> 3); u.pn = 42; const int p = c & 7, S = so.ntk / 2; const int s0 = (p * S) / 8, s1 = ((p + 1) * S) / 8; u.k0 = 2 * s0; u.nt = 2 * (s1 - s0); u.part = p; return true;
    }
    __device__ __forceinline__ void a_ready(const Unit&) const {}
    __device__ __forceinline__ void done(const Unit&) const {}
};
struct SplitOrder {
    StaticOrder so; int c, S;
    __host__ __device__ void init(int K, int G_, int c_) { so.init(8192, 2048, K, G_, c_); c = c_; S = K / 128; }
    __host__ __device__ bool next(int i, Unit& u) const {
        if (i == 0) return so.next(0, u);
        if (i != 1) return false;
        const int t = c >> 3, p = c & 7; u.pm = 32 + (t >> 3); u.pn = t & 7; const int s0 = (p * S) / 8, s1 = ((p + 1) * S) / 8; u.k0 = 2 * s0; u.nt = 2 * (s1 - s0); u.part = p; return true;
    }
    __device__ __forceinline__ void a_ready(const Unit&) const {}
    __device__ __forceinline__ void done(const Unit&) const {}
};

__device__ __forceinline__ unsigned cvt_pk_bf16(float lo, float hi) { unsigned r; asm volatile("v_cvt_pk_bf16_f32 %0, %1, %2" : "=v"(r) : "v"(lo), "v"(hi)); return r; }

struct EpiBf16 {
    static constexpr bool PERM = true, AFTER_DRAIN = false, ROWPERM = false;
    bf16_t* O; int ldc;
    __device__ __forceinline__ void operator()(const f32x4 (&acc)[2][2][4][2], const Unit& u, int wr, int wc, int fr, int fq) const {
        const int row0 = u.pm * BM + wr * 64 + fr; const int col0 = u.pn * BM + wc * 32 + 8 * fq;
#pragma unroll
        for (int ai = 0; ai < 2; ++ai)
#pragma unroll
            for (int m = 0; m < 4; ++m) { bf16_t* rowp = O + (size_t)(row0 + ai * HALF + m * 16) * ldc + col0;
#pragma unroll
                for (int bj = 0; bj < 2; ++bj) { const f32x4 v0 = acc[ai][bj][m][0], v1 = acc[ai][bj][m][1];
                    u32x4 w; w.x = cvt_pk_bf16(v0[0], v0[1]); w.y = cvt_pk_bf16(v0[2], v0[3]); w.z = cvt_pk_bf16(v1[0], v1[1]); w.w = cvt_pk_bf16(v1[2], v1[3]);
                    *(u32x4*)(rowp + bj * HALF) = w; } }
    }
};
struct EpiResid {
    static constexpr bool PERM = true, AFTER_DRAIN = false, ROWPERM = false;
    const float* xp; const float* xs; float* X; const float* gate; float* slab;
    __device__ __forceinline__ void operator()(const f32x4 (&acc)[2][2][4][2], const Unit& u, int wr, int wc, int fr, int fq) const {
        const int row0 = u.pm * BM + wr * 64 + fr, col0 = u.pn * BM + wc * 32 + 8 * fq;
        if (u.part >= 0) {
            bf16_t* sb = (bf16_t*)slab + ((size_t)u.part * 1024 + (row0 - 8192)) * 2048 + col0;
#pragma unroll
            for (int ai = 0; ai < 2; ++ai)
#pragma unroll
                for (int m = 0; m < 4; ++m)
#pragma unroll
                    for (int bj = 0; bj < 2; ++bj) { const f32x4 v0 = acc[ai][bj][m][0], v1 = acc[ai][bj][m][1];
                        u32x4 w; w.x = cvt_pk_bf16(v0[0], v0[1]); w.y = cvt_pk_bf16(v0[2], v0[3]); w.z = cvt_pk_bf16(v1[0], v1[1]); w.w = cvt_pk_bf16(v1[2], v1[3]);
                        *(u32x4*)(sb + (size_t)(ai * HALF + m * 16) * 2048 + bj * HALF) = w; }
            return; }
        const int bidx0 = (u.pm * BM < 8192) ? ((u.pm * BM) >> 11) : 4 + ((u.pm * BM - 8192) >> 3);
        const bool uni = u.pm * BM < 8192;
        f32x4 gvu[2][2];
#pragma unroll
        for (int bj = 0; bj < 2; ++bj)
#pragma unroll
            for (int n = 0; n < 2; ++n) gvu[bj][n] = *(const f32x4*)(gate + (size_t)bidx0 * 12288 + col0 + bj * HALF + n * 4);
#pragma unroll
        for (int h2 = 0; h2 < 4; ++h2) { f32x4 xv[2][2][2];
#pragma unroll
            for (int e = 0; e < 2; ++e) { const int jj = 2 * h2 + e, ai = jj >> 2, m = jj & 3; const int row = row0 + ai * HALF + m * 16;
                const float* xin = (row < 8192) ? xp + (size_t)row * 2048 : xs + (size_t)(row - 8192) * 2048;
#pragma unroll
                for (int bj = 0; bj < 2; ++bj)
#pragma unroll
                    for (int n = 0; n < 2; ++n) xv[e][bj][n] = *(const f32x4*)(xin + col0 + bj * HALF + n * 4); }
#pragma unroll
            for (int e = 0; e < 2; ++e) { const int jj = 2 * h2 + e, ai = jj >> 2, m = jj & 3; const int row = row0 + ai * HALF + m * 16;
                const int bidx = (row < 8192) ? (row >> 11) : 4 + ((row - 8192) >> 3);
                const float* gp = gate + (size_t)bidx * 12288; float* outp = X + (size_t)row * 2048;
#pragma unroll
                for (int bj = 0; bj < 2; ++bj)
#pragma unroll
                    for (int n = 0; n < 2; ++n) { const int c = col0 + bj * HALF + n * 4;
                        const f32x4 gv = uni ? gvu[bj][n] : *(const f32x4*)(gp + c);
                        *(f32x4*)(outp + c) = xv[e][bj][n] + gv * acc[ai][bj][m][n]; } }
            asm volatile("" ::: "memory"); }
    }
};


struct EpiAct {
    static constexpr bool PERM = true, AFTER_DRAIN = false, ROWPERM = true;
    static constexpr int FFN = 5504;
    bf16_t* ACT; const float* cw; const float* cbias; const float* st; float* sconv; float* HALO; float* FIXA; float* FIXB; float* slab;
    static __device__ __forceinline__ float silu1(float x) { return x * __builtin_amdgcn_rcpf(1.0f + __expf(-x)); }
    static __device__ __forceinline__ f32x4 silu4(f32x4 v) { return (f32x4){silu1(v.x), silu1(v.y), silu1(v.z), silu1(v.w)}; }
    static __device__ __forceinline__ float bp1(float v, int addr) { return __builtin_bit_cast(float, __builtin_amdgcn_ds_bpermute(addr, __builtin_bit_cast(int, v))); }
    static __device__ __forceinline__ f32x4 shl1(f32x4 v, int lane) { const int ad = (lane - 1) << 2; return (f32x4){bp1(v.x, ad), bp1(v.y, ad), bp1(v.z, ad), bp1(v.w, ad)}; }
    __device__ __forceinline__ void operator()(const f32x4 (&acc)[2][2][4][2], const Unit& u, int wr, int wc, int fr, int fq) const {
        const int tok0 = u.pm * BM + 128 * wr + 8 * fr;
        if (u.part >= 0) {
#pragma unroll
            for (int ai = 0; ai < 2; ++ai)
#pragma unroll
                for (int m = 0; m < 4; ++m) { float* q = slab + ((size_t)u.part * 3072 + (tok0 + 4 * ai + m - 6144)) * 256 + wc * 32 + 8 * fq;
#pragma unroll
                    for (int bj = 0; bj < 2; ++bj) { *(f32x4*)(q + bj * HALF) = acc[ai][bj][m][0]; *(f32x4*)(q + bj * HALF + 4) = acc[ai][bj][m][1]; } }
            return; }
        const bool sample = u.pm >= 32; const int lane = fq * 16 + fr; const int c8 = u.pn * 128 + wc * 32 + 8 * fq;
        const bool defer = !sample && fr == 0 && (tok0 & 2047) != 0; const int blk128 = tok0 >> 7; const int seq = (tok0 - 8192) >> 3;
        f32x4 w0[2], w1[2], w2[2], cb[2], am1[2], am2[2];
#pragma unroll
        for (int n = 0; n < 2; ++n) { const int c4 = c8 + 4 * n; w0[n] = *(const f32x4*)(cw + c4); w1[n] = *(const f32x4*)(cw + FFN + c4); w2[n] = *(const f32x4*)(cw + 2 * FFN + c4); cb[n] = *(const f32x4*)(cbias + c4);
            if (sample) { am2[n] = *(const f32x4*)(st + ((size_t)seq * 2 + 0) * FFN + c4); am1[n] = *(const f32x4*)(st + ((size_t)seq * 2 + 1) * FFN + c4);
                *(f32x4*)(sconv + ((size_t)seq * 2 + 0) * FFN + c4) = acc[1][0][2][n]; *(f32x4*)(sconv + ((size_t)seq * 2 + 1) * FFN + c4) = acc[1][0][3][n]; }
            else { am2[n] = shl1(acc[1][0][2][n], lane); am1[n] = shl1(acc[1][0][3][n], lane);
                if (fr == 0) { am1[n] = (f32x4){0.f, 0.f, 0.f, 0.f}; am2[n] = am1[n]; }
                if (fr == 15) { *(f32x4*)(HALO + ((size_t)blk128 * 2 + 0) * FFN + c4) = acc[1][0][2][n]; *(f32x4*)(HALO + ((size_t)blk128 * 2 + 1) * FFN + c4) = acc[1][0][3][n]; }
                if (defer) { *(f32x4*)(FIXA + ((size_t)blk128 * 2 + 0) * FFN + c4) = acc[0][0][0][n]; *(f32x4*)(FIXA + ((size_t)blk128 * 2 + 1) * FFN + c4) = acc[0][0][1][n];
                             *(f32x4*)(FIXB + ((size_t)blk128 * 2 + 0) * FFN + c4) = acc[0][1][0][n]; *(f32x4*)(FIXB + ((size_t)blk128 * 2 + 1) * FFN + c4) = acc[0][1][1][n]; } } }
#pragma unroll
        for (int jj = 0; jj < 8; ++jj) { const int ai = jj >> 2, m = jj & 3; u32x4 w;
#pragma unroll
            for (int n = 0; n < 2; ++n) { const f32x4 a0 = acc[ai][0][m][n];
                const f32x4 p1 = (jj == 0) ? am1[n] : acc[(jj - 1) >> 2][0][(jj - 1) & 3][n];
                const f32x4 p2 = (jj == 0) ? am2[n] : (jj == 1) ? am1[n] : acc[(jj - 2) >> 2][0][(jj - 2) & 3][n];
                const f32x4 o = silu4(cb[n] + w0[n] * p2 + w1[n] * p1 + w2[n] * a0) * acc[ai][1][m][n];
                if (n == 0) { w.x = cvt_pk_bf16(o[0], o[1]); w.y = cvt_pk_bf16(o[2], o[3]); } else { w.z = cvt_pk_bf16(o[0], o[1]); w.w = cvt_pk_bf16(o[2], o[3]); } }
            if (!(defer && jj < 2)) *(u32x4*)(ACT + (size_t)(tok0 + jj) * FFN + c8) = w; }
    }
};

struct EpiBf16R {
    static constexpr bool PERM = true, AFTER_DRAIN = false, ROWPERM = true;
    bf16_t* O; int ldc;
    __device__ __forceinline__ void operator()(const f32x4 (&acc)[2][2][4][2], const Unit& u, int wr, int wc, int fr, int fq) const {
        const int tok0 = u.pm * BM + 128 * wr + 8 * fr; const int col0 = u.pn * BM + wc * 32 + 8 * fq;
#pragma unroll
        for (int ai = 0; ai < 2; ++ai)
#pragma unroll
            for (int m = 0; m < 4; ++m) { bf16_t* rowp = O + (size_t)(tok0 + 4 * ai + m) * ldc + col0;
#pragma unroll
                for (int bj = 0; bj < 2; ++bj) { const f32x4 v0 = acc[ai][bj][m][0], v1 = acc[ai][bj][m][1];
                    u32x4 w; w.x = cvt_pk_bf16(v0[0], v0[1]); w.y = cvt_pk_bf16(v0[2], v0[3]); w.z = cvt_pk_bf16(v1[0], v1[1]); w.w = cvt_pk_bf16(v1[2], v1[3]);
                    *(u32x4*)(rowp + bj * HALF) = w; } }
    }
};

template <class Epi, class Sched, bool ALIGN_EPI = false, bool SP2 = false>
__device__ __forceinline__ void gemm_phase(PG8_LAS unsigned char* lds, const Gemm g, const Sched& S, const Epi& E, const int tid) {
    const int wid = __builtin_amdgcn_readfirstlane(tid >> 6), lane = tid & 63, wr = wid >> 2, wc = wid & 3, fr = lane & 15, fq = lane >> 4;
    const int K = g.K;
    unsigned voffA[2], voffB[2];
#pragma unroll
    for (int i = 0; i < 2; ++i) { int R, C; stage_rc(tid * 16 + i * 8192, R, C); const int Rb = Epi::PERM ? ((R & ~31) + perm32(R & 31)) : R;
        const int Ra = Epi::ROWPERM ? (128 * (R >> 6) + 8 * (R & 15) + ((R >> 4) & 3)) : R;
        voffA[i] = (unsigned)(Ra * K + C) * 2u; voffB[i] = (unsigned)(Rb * K + C) * 2u; }
    const size_t kstep = (size_t)(BK * 2);
    const size_t hstep = (size_t)HALF * K * 2;
    const size_t hstepA = Epi::ROWPERM ? (size_t)4 * K * 2 : hstep;
    const size_t tstep = 2 * hstep;
    const unsigned ldsw = (unsigned)wid * 1024u;
    const int aoff = lds_byte(wr * 64 + fr, fq * 8), boff = lds_byte(wc * 32 + fr, fq * 8);
#define PG8_SA(b, h) (((b) * 2 + (h)) * HTB)
#define PG8_SB(b, h) ((4 + (b) * 2 + (h)) * HTB)
#define PG8_STAGE(bufoff, gbase, voff) do { _Pragma("unroll") for (int _i = 0; _i < 2; ++_i) \
        __builtin_amdgcn_global_load_lds((const unsigned*)((const char*)(gbase) + (voff)[_i]), (PG8_LAS unsigned*)(lds + (bufoff) + ldsw + _i * 8192), 16, 0, 0); } while (0)
#define PG8_LDA(dst, b, h) do { _Pragma("unroll") for (int m = 0; m < 4; ++m) _Pragma("unroll") for (int k = 0; k < 2; ++k) dst[m][k] = *(const PG8_LAS bf16x8*)(lds + PG8_SA(b, h) + aoff + m * 2048 + k * 1024); } while (0)
#define PG8_LDB(dst, b, h) do { _Pragma("unroll") for (int n = 0; n < 2; ++n) _Pragma("unroll") for (int k = 0; k < 2; ++k) dst[n][k] = *(const PG8_LAS bf16x8*)(lds + PG8_SB(b, h) + boff + n * 2048 + k * 1024); } while (0)
#define PG8_MMA(ai, bj, At, Bt) do { __builtin_amdgcn_s_setprio(1); _Pragma("unroll") for (int m = 0; m < 4; ++m) _Pragma("unroll") for (int n = 0; n < 2; ++n) _Pragma("unroll") for (int k = 0; k < 2; ++k) \
        acc[ai][bj][m][n] = __builtin_amdgcn_mfma_f32_16x16x32_bf16(Bt[n][k], At[m][k], acc[ai][bj][m][n], 0, 0, 0); __builtin_amdgcn_s_setprio(0); } while (0)
#define PG8_WAIT_V(n) asm volatile("s_waitcnt vmcnt(" #n ")" ::: "memory")
#define PG8_WAIT_L(n) asm volatile("s_waitcnt lgkmcnt(" #n ")" ::: "memory")
#define PG8_BAR __builtin_amdgcn_s_barrier()
#define PG8_SCHED __builtin_amdgcn_sched_barrier(0)
    Unit cur, nxt; int ui = 0;
    if (!S.next(0, cur)) return;
    f32x4 acc[2][2][4][2];
#pragma unroll
    for (int a = 0; a < 2; ++a)
#pragma unroll
        for (int b = 0; b < 2; ++b)
#pragma unroll
            for (int m = 0; m < 4; ++m)
#pragma unroll
                for (int n = 0; n < 2; ++n) acc[a][b][m][n] = (f32x4){0.f, 0.f, 0.f, 0.f};
    bf16x8 At[4][2], B0[2][2], B1[2][2];
    const char* cA = (const char*)g.A + (size_t)cur.pm * tstep + (size_t)cur.k0 * kstep; const char* cB = (const char*)g.Bt + (size_t)cur.pn * tstep + (size_t)cur.k0 * kstep;
    S.a_ready(cur);
    if constexpr (SP2) {
        PG8_STAGE(PG8_SB(0, 0), cB, voffB); PG8_STAGE(PG8_SB(0, 1), cB + hstep, voffB); PG8_STAGE(PG8_SA(0, 0), cA, voffA); PG8_STAGE(PG8_SA(0, 1), cA + hstepA, voffA);
        if (wr == 1) PG8_BAR;
        PG8_WAIT_V(2); PG8_BAR;
        PG8_STAGE(PG8_SB(1, 0), cB + kstep, voffB); PG8_STAGE(PG8_SA(1, 0), cA + kstep, voffA); PG8_STAGE(PG8_SB(1, 1), cB + hstep + kstep, voffB);
        PG8_WAIT_V(6); PG8_BAR;
    } else {
        PG8_STAGE(PG8_SB(0, 0), cB, voffB); PG8_STAGE(PG8_SA(0, 0), cA, voffA); PG8_STAGE(PG8_SB(0, 1), cB + hstep, voffB); PG8_STAGE(PG8_SA(0, 1), cA + hstepA, voffA);
        if (wr == 1) PG8_BAR;
        PG8_WAIT_V(4); PG8_BAR;
        PG8_STAGE(PG8_SB(1, 0), cB + kstep, voffB); PG8_STAGE(PG8_SA(1, 0), cA + kstep, voffA); PG8_STAGE(PG8_SB(1, 1), cB + hstep + kstep, voffB);
        PG8_WAIT_V(6); PG8_BAR;
    }
    for (;;) {
        const bool has_next = S.next(ui + 1, nxt);
        const char* nA = has_next ? (const char*)g.A + (size_t)nxt.pm * tstep + (size_t)nxt.k0 * kstep : cA; const char* nB = has_next ? (const char*)g.Bt + (size_t)nxt.pn * tstep + (size_t)nxt.k0 * kstep : cB;
        const int nt = cur.nt;
        for (int t = 0; t < nt; t += 2) {
            const bool last = (t == nt - 2);
            const char* a1 = cA + (size_t)(t + 1) * kstep;
            const char* a2 = last ? nA : cA + (size_t)(t + 2) * kstep; const char* b2 = last ? nB : cB + (size_t)(t + 2) * kstep;
            const char* a3 = a2 + kstep; const char* b3 = b2 + kstep;
            if (last && has_next) S.a_ready(nxt);
            if constexpr (SP2) {
            PG8_LDB(B0, 0, 0); PG8_LDB(B1, 0, 1); PG8_SCHED; PG8_LDA(At, 0, 0); PG8_STAGE(PG8_SA(1, 1), a1 + hstepA, voffA);
            PG8_WAIT_V(8); PG8_WAIT_L(0); PG8_BAR; PG8_MMA(0, 0, At, B0); PG8_MMA(0, 1, At, B1); PG8_BAR; PG8_SCHED;
            PG8_LDA(At, 0, 1); PG8_STAGE(PG8_SB(0, 0), b2, voffB); PG8_STAGE(PG8_SB(0, 1), b2 + hstep, voffB); PG8_STAGE(PG8_SA(0, 0), a2, voffA);
            PG8_WAIT_V(8); PG8_WAIT_L(0); PG8_BAR; PG8_MMA(1, 0, At, B0); PG8_MMA(1, 1, At, B1); PG8_BAR; PG8_SCHED;
            PG8_LDB(B0, 1, 0); PG8_LDB(B1, 1, 1); PG8_SCHED; PG8_LDA(At, 1, 0); PG8_STAGE(PG8_SA(0, 1), a2 + hstepA, voffA);
            PG8_WAIT_V(8); PG8_WAIT_L(0); PG8_BAR; PG8_MMA(0, 0, At, B0); PG8_MMA(0, 1, At, B1); PG8_BAR; PG8_SCHED;
            PG8_LDA(At, 1, 1); PG8_STAGE(PG8_SB(1, 0), b3, voffB); PG8_STAGE(PG8_SB(1, 1), b3 + hstep, voffB); PG8_STAGE(PG8_SA(1, 0), a3, voffA);
            PG8_WAIT_V(8); PG8_WAIT_L(0); PG8_BAR; PG8_MMA(1, 0, At, B0); PG8_MMA(1, 1, At, B1); PG8_BAR; PG8_SCHED;
            } else {
            PG8_LDB(B0, 0, 0); PG8_SCHED; PG8_LDA(At, 0, 0); PG8_STAGE(PG8_SA(1, 1), a1 + hstepA, voffA);
            PG8_WAIT_L(8); PG8_BAR; PG8_WAIT_L(0); PG8_MMA(0, 0, At, B0); PG8_BAR; PG8_SCHED;
            PG8_LDB(B1, 0, 1); PG8_STAGE(PG8_SB(0, 0), b2, voffB);
            PG8_BAR; PG8_WAIT_L(0); PG8_MMA(0, 1, At, B1); PG8_BAR;
            PG8_LDA(At, 0, 1); PG8_STAGE(PG8_SA(0, 0), a2, voffA);
            PG8_BAR; PG8_WAIT_L(0); PG8_MMA(1, 0, At, B0); PG8_BAR; PG8_SCHED;
            PG8_STAGE(PG8_SB(0, 1), b2 + hstep, voffB);
            PG8_WAIT_V(6); PG8_BAR; PG8_MMA(1, 1, At, B1); PG8_BAR;
            PG8_LDB(B0, 1, 0); PG8_SCHED; PG8_LDA(At, 1, 0); PG8_STAGE(PG8_SA(0, 1), a2 + hstepA, voffA);
            PG8_WAIT_L(8); PG8_BAR; PG8_WAIT_L(0); PG8_MMA(0, 0, At, B0); PG8_BAR; PG8_SCHED;
            PG8_LDB(B1, 1, 1); PG8_STAGE(PG8_SB(1, 0), b3, voffB);
            PG8_BAR; PG8_WAIT_L(0); PG8_MMA(0, 1, At, B1); PG8_BAR;
            PG8_LDA(At, 1, 1); PG8_STAGE(PG8_SA(1, 0), a3, voffA);
            PG8_BAR; PG8_WAIT_L(0); PG8_MMA(1, 0, At, B0); PG8_BAR; PG8_SCHED;
            PG8_STAGE(PG8_SB(1, 1), b3 + hstep, voffB);
            PG8_WAIT_V(6); PG8_BAR; PG8_MMA(1, 1, At, B1); PG8_BAR;
            }
        }
        if constexpr (ALIGN_EPI) { if (wr == 0) PG8_BAR; }
        if constexpr (!Epi::AFTER_DRAIN) { int ln_; asm volatile("v_mbcnt_lo_u32_b32 %0, -1, 0\n\tv_mbcnt_hi_u32_b32 %0, -1, %0" : "=v"(ln_));
            E(acc, cur, wr, wc, ln_ & 15, ln_ >> 4); S.done(cur); }
        if (!has_next) break;
#pragma unroll
        for (int a = 0; a < 2; ++a)
#pragma unroll
            for (int b = 0; b < 2; ++b)
#pragma unroll
                for (int m = 0; m < 4; ++m)
#pragma unroll
                    for (int n = 0; n < 2; ++n) acc[a][b][m][n] = (f32x4){0.f, 0.f, 0.f, 0.f};
        cur = nxt; cA = nA; cB = nB; ++ui;
        if constexpr (ALIGN_EPI) { if (wr == 1) PG8_BAR; }
    }
    PG8_WAIT_V(0);
    if constexpr (!ALIGN_EPI) { if (wr == 0) PG8_BAR; }
    PG8_BAR;
#undef PG8_SA
#undef PG8_SB
#undef PG8_STAGE
#undef PG8_LDA
#undef PG8_LDB
#undef PG8_MMA
#undef PG8_WAIT_V
#undef PG8_WAIT_L
#undef PG8_BAR
#undef PG8_SCHED
}
}

constexpr int NWAVES = 8, NTHR = 512;
constexpr int DM = 2048, PB = 4, PSEQ = 2048, DEPTH = 2, SB = 128, SSEQ = 8, PAST = 16384;
constexpr int MP = PB * PSEQ, MS = SB * SSEQ, MT = MP + MS;
constexpr int NCOND = PB + SB;
constexpr int D_SSM = 512, D_RET = 1024, D_POOL = 512, NG = 32, NST = 64, NH = 8, HD = 128, FF = 5504, DIN = 5120, NMOD = 6 * DM;
constexpr int C_UA = 0, C_Q = 512, C_K = 1536, C_V = 2560, C_G = 3584, C_UC = 4608;
constexpr int NCHUNK = PSEQ / 128;
constexpr int NBLK = PSEQ / 32;
constexpr float EPS = 1e-6f;

constexpr size_t al256(size_t x) { return (x + 255) & ~(size_t)255; }
constexpr size_t WS_CTL = 0, CTL_ZERO_BYTES = 1u << 20;
constexpr size_t WS_ROPEP = CTL_ZERO_BYTES;
constexpr size_t WS_ROPES = WS_ROPEP + (size_t)PSEQ * 64 * 8;
constexpr size_t WS_SAB = WS_ROPES + al256(8 * 64 * 8);
constexpr size_t WS_SA32 = WS_SAB + (size_t)DEPTH * NG * NST * 8;
constexpr size_t WS_SBB = WS_SA32 + (size_t)DEPTH * NG * NST * 8;
constexpr size_t WS_SCM = WS_SBB + (size_t)DEPTH * NG * 128 * 16 * 2;
constexpr size_t WS_SC = WS_SCM + (size_t)DEPTH * NG * 16 * 128 * 2;
constexpr size_t WS_MOD = WS_SC + (size_t)144 * DM * 2;
constexpr size_t WS_E = al256(WS_MOD + (size_t)DEPTH * NCOND * NMOD * 4);
constexpr size_t WS_HIN = WS_E + (size_t)PB * NBLK * NG * NST * 8;
constexpr size_t WS_W = al256(WS_HIN + (size_t)PB * NBLK * NG * NST * 8);
constexpr size_t W_IN = 0, W_OUT = W_IN + (size_t)DIN * DM * 2, W_UP = W_OUT + (size_t)DM * DM * 2, W_DOWN = W_UP + (size_t)2 * FF * DM * 2,
                 W_GLU = W_DOWN + (size_t)DM * FF * 2, W_POOL = W_GLU + (size_t)D_SSM * D_SSM * 2, W_LAYER = W_POOL + (size_t)4 * 128 * 128 * 2;
constexpr size_t WS_X = al256(WS_W + DEPTH * W_LAYER);
constexpr size_t WS_H = WS_X + (size_t)MT * DM * 4;
constexpr size_t WS_R1 = WS_H + (size_t)MT * DM * 2;
constexpr size_t R1_PROJ = 0, R1_MIX = R1_PROJ + (size_t)MT * DIN * 2, R1_KV = R1_MIX + (size_t)MT * DM * 2,
                 R1_SPT = R1_KV + (size_t)PB * NH * NCHUNK * 128 * 128 * 4, R1_END = R1_SPT + (size_t)PB * NH * NCHUNK * 128 * 128 * 2;
constexpr size_t R1_AB_BYTES = (size_t)MT * 2 * FF * 2;
constexpr size_t R1_BYTES = R1_END > R1_AB_BYTES ? R1_END : R1_AB_BYTES;
constexpr size_t WS_ACT = al256(WS_R1 + R1_BYTES);
constexpr size_t WS_END = WS_ACT + (size_t)MT * FF * 2;

constexpr size_t O_YP = 0, O_YS = O_YP + (size_t)MP * DM, O_PRE = O_YS + (size_t)MS * DM, O_PIM = O_PRE + (size_t)DEPTH * PB * NG * NST,
                 O_PRET = O_PIM + (size_t)DEPTH * PB * NG * NST, O_PPOOL = O_PRET + (size_t)DEPTH * PB * NH * HD * HD, O_PCONV = O_PPOOL + (size_t)DEPTH * PB * 15 * D_POOL,
                 O_SRE = O_PCONV + (size_t)DEPTH * PB * 2 * FF, O_SIM = O_SRE + (size_t)DEPTH * SB * NG * NST, O_SRET = O_SIM + (size_t)DEPTH * SB * NG * NST,
                 O_SPOOL = O_SRET + (size_t)DEPTH * SB * NH * HD * HD, O_SCONV = O_SPOOL + (size_t)DEPTH * SB * 15 * D_POOL, O_END = O_SCONV + (size_t)DEPTH * SB * 2 * FF;

constexpr int CW_BAR = 4096;
constexpr int RING_BYTES = 131072;
constexpr int LDSCTL_OFF = RING_BYTES, MISC_OFF = LDSCTL_OFF + 320;
constexpr int LDS_BYTES = 147456;

#define GAS __attribute__((address_space(1)))
#define LAS __attribute__((address_space(3)))
typedef unsigned short bf16;
typedef unsigned v4u __attribute__((ext_vector_type(4)));
typedef unsigned v2u __attribute__((ext_vector_type(2)));
typedef float f32x4 __attribute__((ext_vector_type(4)));
typedef float f32x2 __attribute__((ext_vector_type(2)));
typedef short bf16x8 __attribute__((ext_vector_type(8)));
#define RLX_AGENT __ATOMIC_RELAXED, __HIP_MEMORY_SCOPE_AGENT
#define LDS_WAIT() asm volatile("s_waitcnt lgkmcnt(0)" ::: "memory")
#define VM_WAIT() asm volatile("s_waitcnt vmcnt(0)" ::: "memory")
#define CFENCE() asm volatile("" ::: "memory")
__device__ __forceinline__ unsigned pk2(float lo, float hi) { unsigned r; asm("v_cvt_pk_bf16_f32 %0, %1, %2" : "=v"(r) : "v"(lo), "v"(hi)); return r; }
__device__ __forceinline__ unsigned f2bf(float f) { return pk2(f, f) & 0xffffu; }
__device__ __forceinline__ float bf2f(unsigned b) { return __builtin_bit_cast(float, b << 16); }
__device__ __forceinline__ float bflo(unsigned w) { return __builtin_bit_cast(float, w << 16); }
__device__ __forceinline__ float bfhi(unsigned w) { return __builtin_bit_cast(float, w & 0xffff0000u); }
__device__ __forceinline__ float fsigmoid(float x) { return __builtin_amdgcn_rcpf(1.0f + __expf(-x)); }
__device__ __forceinline__ float fsilu(float x) { return x * __builtin_amdgcn_rcpf(1.0f + __expf(-x)); }
__device__ __forceinline__ float gelu_tanh(float x) { const float u = 0.7978845608028654f * (x + 0.044715f * x * x * x); const float e = __expf(2.0f * u); const float th = 1.0f - 2.0f * __builtin_amdgcn_rcpf(e + 1.0f); return 0.5f * x * (1.0f + th); }
__device__ __forceinline__ float xshfl(float v, int o, int lane) { return __builtin_bit_cast(float, __builtin_amdgcn_ds_bpermute((lane ^ o) << 2, __builtin_bit_cast(int, v))); }
__device__ __forceinline__ float wave_sum(float v, int lane) {
#pragma unroll
    for (int o = 1; o < 64; o <<= 1) v += xshfl(v, o, lane);
    return v;
}
__device__ __forceinline__ float sum16(float v, int lane) {
#pragma unroll
    for (int o = 1; o < 16; o <<= 1) v += xshfl(v, o, lane);
    return v;
}
__device__ __forceinline__ void sincos_acc(float xf, float& c, float& s) {
    const double x = (double)xf;
    const double n = __builtin_rint(x * 0.63661977236758134308);
    double r = __builtin_fma(-n, 1.57079632673412561417e+00, x);
    r = __builtin_fma(-n, 6.07710050650619224932e-11, r);
    const double z = r * r;
    const double sp = r + r * z * (-1.66666666666666324348e-01 + z * (8.33333333332248946124e-03 + z * (-1.98412698298579493134e-04 + z * (2.75573137070700676789e-06 + z * (-2.50507602534068634195e-08 + z * 1.58969099521155010221e-10)))));
    const double cp = 1.0 - 0.5 * z + z * z * (4.16666666666666019037e-02 + z * (-1.38888888888741095749e-03 + z * (2.48015872894767294178e-05 + z * (-2.75573143513906633035e-07 + z * (2.08757232129817482790e-09 + z * -1.13596475577881948265e-11)))));
    const int q = ((int)n) & 3;
    const double sv = (q == 0) ? sp : (q == 1) ? cp : (q == 2) ? -sp : -cp;
    const double cv = (q == 0) ? cp : (q == 1) ? -sp : (q == 2) ? -cp : sp;
    s = (float)sv; c = (float)cv;
}
__device__ __forceinline__ float ret_lg(int h) {
    const float x = __builtin_bit_cast(float, (unsigned)((127 - 5 - h) << 23));
    return -x * (1.0f + x * (0.5f + x * (0.33333334f + x * (0.25f + x * (0.2f + x * (0.16666667f + x * 0.14285715f))))));
}

__device__ const float rope_inv[64] = {
1.000000000e+00f, 8.659643531e-01f, 7.498942614e-01f, 6.493816376e-01f, 5.623413324e-01f, 4.869675338e-01f, 4.216965139e-01f, 3.651741147e-01f, 3.162277639e-01f, 2.738419771e-01f, 2.371373773e-01f, 2.053525001e-01f, 1.778279394e-01f, 1.539926529e-01f, 1.333521307e-01f, 1.154782027e-01f, 1.000000015e-01f, 8.659642935e-02f, 7.498941571e-02f, 6.493816525e-02f, 5.623413250e-02f, 4.869675264e-02f, 4.216965288e-02f, 3.651741147e-02f, 3.162277490e-02f, 2.738419734e-02f, 2.371373773e-02f, 2.053525113e-02f, 1.778279431e-02f, 1.539926510e-02f, 1.333521493e-02f, 1.154782064e-02f, 9.999999776e-03f, 8.659643121e-03f, 7.498941850e-03f, 6.493816152e-03f, 5.623413250e-03f, 4.869675264e-03f, 4.216964822e-03f, 3.651741194e-03f, 3.162277630e-03f, 2.738419687e-03f, 2.371373586e-03f, 2.053524833e-03f, 1.778279431e-03f, 1.539926510e-03f, 1.333521446e-03f, 1.154781901e-03f, 1.000000047e-03f, 8.659643354e-04f, 7.498942432e-04f, 6.493816618e-04f, 5.623413017e-04f, 4.869675322e-04f, 4.216965172e-04f, 3.651741426e-04f, 3.162277571e-04f, 2.738419571e-04f, 2.371373703e-04f, 2.053525095e-04f, 1.778279402e-04f, 1.539926452e-04f, 1.333521504e-04f, 1.154782003e-04f };

#define XB_TMO      128
#define XB_XCNT(j)  (256  + 64 * (j))
#define XB_XSUB(j)  (1280 + 64 * (j))
#define XB_XGEN(j)  (2304 + 64 * (j))
#define XB_TOP      3328
#define XB_TOPGEN   3392
#define XCD_BAR_WORDS 3456
#define XB_SPIN_CAP (1u << 18)
__device__ __forceinline__ unsigned xb_ld(unsigned* p)              { return __hip_atomic_load(p, __ATOMIC_RELAXED, __HIP_MEMORY_SCOPE_AGENT); }
__device__ __forceinline__ unsigned xb_add(unsigned* p, unsigned v) { return __hip_atomic_fetch_add(p, v, __ATOMIC_RELAXED, __HIP_MEMORY_SCOPE_AGENT); }
__device__ __forceinline__ unsigned xb_xcc_id() { return (unsigned)__builtin_amdgcn_s_getreg((3 << 11) | 20) & 0xFu; }
#define XB_SPIN(cond, bar) do { unsigned _sp = 0; while (cond) { __builtin_amdgcn_s_sleep(1); \
    if ((++_sp & 255u) == 0u) { if (xb_ld(&(bar)[XB_TMO])) break; if (_sp > XB_SPIN_CAP) { atomicAdd(&(bar)[XB_TMO], 1u); break; } } } } while (0)
struct XcdBarrier { unsigned* bar; unsigned x; volatile LAS unsigned* st; };
__device__ __forceinline__ XcdBarrier xcd_barrier_post(unsigned* bar, volatile LAS unsigned* st) {
    XcdBarrier b; b.bar = bar; b.x = xb_xcc_id(); b.st = st;
    if (threadIdx.x == 0) (void)xb_add(&bar[XB_XCNT(b.x)], 1u);
    return b;
}
__device__ __forceinline__ void xcd_barrier_complete(unsigned* bar, unsigned x, unsigned& nloc, unsigned& nx) {
    const unsigned G = gridDim.x * gridDim.y * gridDim.z;
    unsigned sum, cnt, mine, sp = 0u;
    for (;;) {
        sum = 0u; cnt = 0u; mine = 0u;
#pragma unroll
        for (unsigned j = 0; j < 16; ++j) { const unsigned c = xb_ld(&bar[XB_XCNT(j)]); sum += c; cnt += (c > 0u) ? 1u : 0u; mine = (j == x) ? c : mine; }
        if (sum == G) break;
        __builtin_amdgcn_s_sleep(1);
        if ((++sp & 255u) == 0u) { if (xb_ld(&bar[XB_TMO])) break; if (sp > XB_SPIN_CAP) { atomicAdd(&bar[XB_TMO], 1u); break; } }
    }
    nloc = mine > 0u ? mine : 1u; nx = cnt > 0u ? cnt : 1u;
}
__device__ __forceinline__ void xcd_barrier(const XcdBarrier& b, const bool leader  ) {
    asm volatile("s_waitcnt vmcnt(0)" ::: "memory");
    __syncthreads();
    if (leader) {
        unsigned* bar = b.bar;
        __builtin_amdgcn_s_waitcnt(0);
        unsigned nloc = b.st[0], nx = b.st[1];
        if (nloc == 0u) { xcd_barrier_complete(bar, b.x, nloc, nx); b.st[0] = nloc; b.st[1] = nx; }
        const unsigned old = xb_add(&bar[XB_XSUB(b.x)], 1u);
        const unsigned gen = old / nloc;
        if (old + 1u == (gen + 1u) * nloc) {
            __builtin_amdgcn_fence(__ATOMIC_RELEASE, "agent");
            asm volatile("s_waitcnt vmcnt(0)" ::: "memory");
            const unsigned og = xb_add(&bar[XB_TOP], 1u);
            const unsigned tg = og / nx;
            if (og + 1u == (tg + 1u) * nx) xb_add(&bar[XB_TOPGEN], 1u);
            else XB_SPIN(xb_ld(&bar[XB_TOPGEN]) == tg, bar);
            __builtin_amdgcn_fence(__ATOMIC_ACQUIRE, "agent");
            xb_add(&bar[XB_XGEN(b.x)], 1u);
            asm volatile("s_waitcnt vmcnt(0)" ::: "memory");
        } else {
            XB_SPIN(xb_ld(&bar[XB_XGEN(b.x)]) == gen, bar);
            __builtin_amdgcn_fence(__ATOMIC_ACQUIRE, "agent");
            asm volatile("s_waitcnt vmcnt(0)" ::: "memory");
        }
    }
    __syncthreads();
}

struct Args { const float* in[32]; float* out; unsigned char* ws; int ph_lo, ph_hi; };

typedef float f32x3a __attribute__((ext_vector_type(3), aligned(4)));
#define MFMA16(a, b, c) __builtin_amdgcn_mfma_f32_16x16x32_bf16((a), (b), (c), 0, 0, 0)
#define SETTLE1(a) asm volatile("s_nop 15" : "+v"(a))
#define SETTLE4(a, b, c, d) asm volatile("s_nop 15" : "+v"(a), "+v"(b), "+v"(c), "+v"(d))
#define SETTLE8(x) asm volatile("s_nop 15" : "+v"((x)[0]), "+v"((x)[1]), "+v"((x)[2]), "+v"((x)[3]), "+v"((x)[4]), "+v"((x)[5]), "+v"((x)[6]), "+v"((x)[7]))

__device__ __forceinline__ void tr_item(const float* W, int N, int k0, int n0, bf16* WT, int K, int drow0, LAS float* scr, int lane) {
    float tmp[32];
    const float* wp = W + (size_t)(k0 + (lane >> 5)) * N + n0 + (lane & 31);
#pragma unroll
    for (int i = 0; i < 32; ++i) tmp[i] = __builtin_nontemporal_load(wp + (size_t)(2 * i) * N);
#pragma unroll
    for (int i = 0; i < 32; ++i) scr[(2 * i + (lane >> 5)) * 33 + (lane & 31)] = tmp[i];
    LDS_WAIT(); CFENCE();
    const int c = lane & 7;
#pragma unroll
    for (int j = 0; j < 4; ++j) { const int n = (lane >> 3) + 8 * j; const LAS float* s = scr + (8 * c) * 33 + n;
        v4u o; o.x = pk2(s[0 * 33], s[1 * 33]); o.y = pk2(s[2 * 33], s[3 * 33]); o.z = pk2(s[4 * 33], s[5 * 33]); o.w = pk2(s[6 * 33], s[7 * 33]);
        *(GAS v4u*)(WT + (size_t)(drow0 + n) * K + k0 + 8 * c) = o; }
    LDS_WAIT(); CFENCE();
}

constexpr int I_IN = (DM / 64) * (DIN / 32), I_OUT = (DM / 64) * (DM / 32), I_UP = (DM / 64) * (2 * FF / 32), I_DOWN = (FF / 64) * (DM / 32), I_GLU = (D_SSM / 64) * (D_SSM / 32), I_POOL = 4 * 2 * 4;
constexpr int I_LAYER = I_IN + I_OUT + I_UP + I_DOWN + I_GLU + I_POOL, I_PRE = I_IN + I_OUT + I_UP;
constexpr int I_UP3 = 3584, I_UP4 = 5000, I_UPH = I_UP / 2;
__device__ __forceinline__ bool tr_deferred(int l, int r) { return l == 0 ? ((r >= I_IN && r < I_IN + I_OUT + I_UP3 + I_UP4) || (r >= I_PRE && r < I_PRE + I_DOWN)) : (r < I_PRE + I_DOWN); }
__device__ __forceinline__ void tr_dispatch(const Args& a, unsigned char* ws, int l, int r, LAS float* scr, int lane) {
    bf16* wl = (bf16*)(ws + WS_W + (size_t)l * W_LAYER);
    if (r < I_IN) { const int nb = DIN / 32; tr_item(a.in[12] + (size_t)l * DM * DIN, DIN, 64 * (r / nb), 32 * (r % nb), (bf16*)((char*)wl + W_IN), DM, 32 * (r % nb), scr, lane); return; } r -= I_IN;
    if (r < I_OUT) { const int nb = DM / 32; tr_item(a.in[25] + (size_t)l * DM * DM, DM, 64 * (r / nb), 32 * (r % nb), (bf16*)((char*)wl + W_OUT), DM, 32 * (r % nb), scr, lane); return; } r -= I_OUT;
    if (r < I_UP) { const int nb = 2 * FF / 32; const int n0 = 32 * (r % nb); const int part = n0 / FF, c = n0 % FF; const int drow = 256 * (c / 128) + 128 * part + (c % 128);
        tr_item(a.in[27] + (size_t)l * DM * 2 * FF, 2 * FF, 64 * (r / nb), n0, (bf16*)((char*)wl + W_UP), DM, drow, scr, lane); return; } r -= I_UP;
    if (r < I_DOWN) { const int nb = DM / 32; tr_item(a.in[30] + (size_t)l * FF * DM, DM, 64 * (r / nb), 32 * (r % nb), (bf16*)((char*)wl + W_DOWN), FF, 32 * (r % nb), scr, lane); return; } r -= I_DOWN;
    if (r < I_GLU) { const int nb = D_SSM / 32; tr_item(a.in[21] + (size_t)l * D_SSM * D_SSM, D_SSM, 64 * (r / nb), 32 * (r % nb), (bf16*)((char*)wl + W_GLU), D_SSM, 32 * (r % nb), scr, lane); return; } r -= I_GLU;
    { const int gi = r / 8, q = r % 8; tr_item(a.in[23] + ((size_t)l * 4 + gi) * 128 * 128, 128, 64 * (q / 4), 32 * (q % 4), (bf16*)((char*)wl + W_POOL) + (size_t)gi * 128 * 128, 128, 32 * (q % 4), scr, lane); }
}
__device__ __forceinline__ void fill_range(const Args& a, unsigned char* ws, LAS unsigned char* lds, int l, int r0, int n, int fw, int nfw, int lane, int wave) {
    LAS float* scr = (LAS float*)(lds + wave * 16384);
    for (int it = fw; it < n; it += nfw) tr_dispatch(a, ws, l, r0 + it, scr, lane);
}
__device__ __forceinline__ void phase_p0a(const Args& a, unsigned char* ws, LAS unsigned char* lds, int vcu, int G, int tid, int wave, int lane) {
    const int gt = vcu * NTHR + tid, NT = G * NTHR;
    { f32x2* rp = (f32x2*)(ws + WS_ROPEP);
      for (int i = gt; i < PSEQ * 64; i += NT) { const int t = i >> 6, d = i & 63; float c, s; sincos_acc((float)t * rope_inv[d], c, s); rp[i] = (f32x2){c, s}; }
      f32x2* rs = (f32x2*)(ws + WS_ROPES);
      for (int i = gt; i < SSEQ * 64; i += NT) { const int t = i >> 6, d = i & 63; float c, s; sincos_acc((float)(PAST + t) * rope_inv[d], c, s); rs[i] = (f32x2){c, s}; } }
    { bf16* sc = (bf16*)(ws + WS_SC); const float* cp = a.in[7]; const float* cs = a.in[8];
      for (int i = gt; i < 144 * DM; i += NT) { const int r = i / DM, k = i % DM; float v = 0.f; if (r < PB) v = cp[r * DM + k]; else if (r < NCOND) v = cs[(r - PB) * DM + k]; sc[i] = (bf16)f2bf(r < NCOND ? fsilu(v) : 0.f); } }
    { const float* a_re = a.in[13]; const float* a_im = a.in[14]; const float* log_dt = a.in[15]; const float* b_re = a.in[16]; const float* b_im = a.in[17]; const float* c_re = a.in[18]; const float* c_im = a.in[19];
      f32x2* AB = (f32x2*)(ws + WS_SAB); f32x2* A32 = (f32x2*)(ws + WS_SA32); bf16* BB = (bf16*)(ws + WS_SBB); bf16* CM = (bf16*)(ws + WS_SCM);
      for (int u = gt; u < DEPTH * NG * NST * 16; u += NT) { const int i = u >> 4, ch = u & 15, lg = i >> 6, p = i & 63;
        const float dt = expf(log_dt[lg]); const float lr = a_re[i], li = a_im[i];
        const float mag = expf(lr * dt); float cs_, sn_; sincos_acc(li * dt, cs_, sn_);
        const float abr = mag * cs_, abi = mag * sn_; const float den = lr * lr + li * li;
        const float fr = ((abr - 1.0f) * lr + abi * li) / den, fi = (abi * lr - (abr - 1.0f) * li) / den;
        if (ch == 0) { AB[i] = (f32x2){abr, abi};
            float pr = abr, pi = abi;
#pragma unroll
            for (int q = 0; q < 5; ++q) { const float nr = pr * pr - pi * pi, ni = 2.0f * pr * pi; pr = nr; pi = ni; }
            A32[i] = (f32x2){pr, pi}; }
        { const float br = b_re[(size_t)i * 16 + ch], bi = b_im[(size_t)i * 16 + ch];
            BB[((size_t)lg * 128 + p) * 16 + ch] = (bf16)f2bf(fr * br - fi * bi); BB[((size_t)lg * 128 + 64 + p) * 16 + ch] = (bf16)f2bf(fr * bi + fi * br); }
        { CM[((size_t)lg * 16 + ch) * 128 + p] = (bf16)f2bf(c_re[((size_t)lg * 16 + ch) * 64 + p]); CM[((size_t)lg * 16 + ch) * 128 + 64 + p] = (bf16)f2bf(-c_im[((size_t)lg * 16 + ch) * 64 + p]); }
      } }
    LAS float* scr = (LAS float*)(lds + wave * 16384);
    const int gw = vcu * NWAVES + wave, NGW = G * NWAVES;
    for (int it = gw; it < DEPTH * I_LAYER; it += NGW) { const int l = it / I_LAYER, r = it % I_LAYER; if (tr_deferred(l, r)) continue; tr_dispatch(a, ws, l, r, scr, lane); }
}

__device__ __forceinline__ void phase_p0b(const Args& a, unsigned char* ws, LAS unsigned char* lds, int vcu, int G, int tid, int wave, int lane) {
    const bf16* SC = (const bf16*)(ws + WS_SC); float* MOD = (float*)(ws + WS_MOD);
    LAS f32x4* RED = (LAS f32x4*)lds;
    const int ch = wave & 1, kq = wave >> 1, j = lane & 15, kg = lane >> 4;
    (void)G;
    { const int it = vcu;
        const int l = it / (NMOD / 96), n0 = 96 * (it % (NMOD / 96)) + 48 * ch;
        const float* W = a.in[9] + (size_t)l * DM * NMOD;
        f32x4 acc[9][3];
#pragma unroll
        for (int rb = 0; rb < 9; ++rb)
#pragma unroll
            for (int cb = 0; cb < 3; ++cb) acc[rb][cb] = (f32x4){0.f, 0.f, 0.f, 0.f};
        f32x3a wv[8];
        { const float* wp = W + (size_t)(512 * kq + 8 * kg) * NMOD + n0 + 3 * j;
#pragma unroll
          for (int q = 0; q < 8; ++q) wv[q] = __builtin_nontemporal_load((const f32x3a*)(wp + (size_t)q * NMOD)); }
#pragma unroll 1
        for (int ks = 0; ks < 16; ++ks) {
            const int k0 = 512 * kq + 32 * ks;
            bf16x8 Xf[9], Y[3];
#pragma unroll
            for (int rb = 0; rb < 9; ++rb) Xf[rb] = *(const bf16x8*)(SC + (size_t)(16 * rb + j) * DM + k0 + 8 * kg);
#pragma unroll
            for (int cb = 0; cb < 3; ++cb) {
                v4u yb; yb.x = pk2(wv[0][cb], wv[1][cb]); yb.y = pk2(wv[2][cb], wv[3][cb]); yb.z = pk2(wv[4][cb], wv[5][cb]); yb.w = pk2(wv[6][cb], wv[7][cb]); Y[cb] = __builtin_bit_cast(bf16x8, yb); }
            asm volatile("" : "+v"(Y[0]), "+v"(Y[1]), "+v"(Y[2]));
            if (ks + 1 < 16) { const float* wp = W + (size_t)(k0 + 32 + 8 * kg) * NMOD + n0 + 3 * j;
#pragma unroll
                for (int q = 0; q < 8; ++q) wv[q] = __builtin_nontemporal_load((const f32x3a*)(wp + (size_t)q * NMOD)); }
#pragma unroll
            for (int rb = 0; rb < 9; ++rb)
#pragma unroll
                for (int cb = 0; cb < 3; ++cb) acc[rb][cb] = MFMA16(Xf[rb], Y[cb], acc[rb][cb]);
        }
#pragma unroll
        for (int rb = 0; rb < 9; ++rb) SETTLE4(acc[rb][0], acc[rb][1], acc[rb][2], acc[rb][2]);
        if (kq >= 2) {
#pragma unroll
            for (int rb = 0; rb < 9; ++rb)
#pragma unroll
                for (int cb = 0; cb < 3; ++cb) RED[(((kq - 2) * 2 + ch) * 27 + rb * 3 + cb) * 64 + lane] = acc[rb][cb]; }
        __syncthreads();
        if (kq < 2) {
#pragma unroll
            for (int rb = 0; rb < 9; ++rb)
#pragma unroll
                for (int cb = 0; cb < 3; ++cb) acc[rb][cb] += RED[((kq * 2 + ch) * 27 + rb * 3 + cb) * 64 + lane]; }
        __syncthreads();
        if (kq == 1) {
#pragma unroll
            for (int rb = 0; rb < 9; ++rb)
#pragma unroll
                for (int cb = 0; cb < 3; ++cb) RED[(ch * 27 + rb * 3 + cb) * 64 + lane] = acc[rb][cb]; }
        __syncthreads();
        if (kq == 0) {
#pragma unroll
            for (int cb = 0; cb < 3; ++cb) { const float bias = a.in[10][(size_t)l * NMOD + n0 + 3 * j + cb];
#pragma unroll
                for (int rb = 0; rb < 9; ++rb) { const f32x4 sres = acc[rb][cb] + RED[(ch * 27 + rb * 3 + cb) * 64 + lane];
#pragma unroll
                    for (int r = 0; r < 4; ++r) { const int row = 16 * rb + 4 * kg + r; if (row < NCOND) MOD[((size_t)l * NCOND + row) * NMOD + n0 + 3 * j + cb] = sres[r] + bias; } } }
        }
        __syncthreads();
    }
}

__device__ __forceinline__ void load_row(const float* xp, const float* xs, const float* slab, const float* gate  , float* Xout, int m, int lane, f32x4 (&v)[8]) {
    const float* xr = (m < MP) ? xp + (size_t)m * DM : xs + (size_t)(m - MP) * DM;
    const f32x4* x4 = (const f32x4*)xr + lane;
#pragma unroll
    for (int q = 0; q < 8; ++q) v[q] = x4[64 * q];
    if (slab && m >= MP) {
        const f32x4* g4 = (const f32x4*)(gate + (size_t)(PB + ((m - MP) >> 3)) * NMOD) + lane;
        const v2u* s2 = (const v2u*)((const bf16*)slab + (size_t)(m - MP) * DM) + lane;
#pragma unroll
        for (int qh = 0; qh < 2; ++qh) { v2u t[4][8];
#pragma unroll
            for (int e = 0; e < 4; ++e)
#pragma unroll
                for (int p = 0; p < 8; ++p) t[e][p] = __builtin_nontemporal_load(s2 + (size_t)p * (MS * DM / 4) + 64 * (4 * qh + e));
#pragma unroll
            for (int e = 0; e < 4; ++e) { const int q = 4 * qh + e; f32x4 sum = (f32x4){0.f, 0.f, 0.f, 0.f};
#pragma unroll
                for (int p = 0; p < 8; ++p) sum += (f32x4){bflo(t[e][p].x), bfhi(t[e][p].x), bflo(t[e][p].y), bfhi(t[e][p].y)};
                v[q] += g4[64 * q] * sum; ((f32x4*)(Xout + (size_t)m * DM) + lane)[64 * q] = v[q]; } }
    }
}
__device__ __forceinline__ int norm_rows(bool balanced, int vcu, int wave) { return balanced ? (wave < 4 ? 1 : 8) : 5; }
__device__ __forceinline__ int norm_row(bool balanced, int vcu, int G, int wave, int i) {
    if (balanced) return wave < 4 ? MP + vcu * 4 + wave : (vcu * 4 + wave - 4) * 8 + i;
    return vcu * NWAVES + wave + i * (G * NWAVES); }
__device__ __forceinline__ void phase_norm(const float* xp, const float* xs, const float* slab, const float* gate, float* Xout, const float* gamma, const float* modl, int sh_off, int sc_off, bf16* H, int vcu, int G, int wave, int lane) {
    const bool bal = slab != nullptr && G == 256; const int nr = norm_rows(bal, vcu, wave);
    int m = norm_row(bal, vcu, G, wave, 0); if (m >= MT) return;
    f32x4 v[8], A[8], Sh[8]; int cur_b = -1;
    load_row(xp, xs, slab, gate, Xout, m, lane, v);
#pragma unroll 1
    for (int i = 0; i < nr; ++i) {
        const int mn = (i + 1 < nr) ? norm_row(bal, vcu, G, wave, i + 1) : MT; const bool hn = mn < MT;
        f32x4 vn[8];
#pragma unroll
        for (int q = 0; q < 8; ++q) vn[q] = v[q];
        if (hn) load_row(xp, xs, nullptr, gate, Xout, mn, lane, vn);
        const int bidx = (m < MP) ? (m >> 11) : PB + ((m - MP) >> 3);
        if (bidx != cur_b) { cur_b = bidx;
            const f32x4* g4 = (const f32x4*)gamma + lane; const f32x4* sc4 = (const f32x4*)(modl + (size_t)bidx * NMOD + sc_off) + lane; const f32x4* sh4 = (const f32x4*)(modl + (size_t)bidx * NMOD + sh_off) + lane;
#pragma unroll
            for (int q = 0; q < 8; ++q) { A[q] = g4[64 * q] * (sc4[64 * q] + 1.0f); Sh[q] = sh4[64 * q]; } }
        float ss = 0.f;
#pragma unroll
        for (int q = 0; q < 8; ++q) ss += (v[q].x * v[q].x + v[q].y * v[q].y) + (v[q].z * v[q].z + v[q].w * v[q].w);
        const float r = 1.0f / sqrtf(wave_sum(ss, lane) * (1.0f / DM) + EPS);
        v2u* o = (v2u*)(H + (size_t)m * DM) + lane;
#pragma unroll
        for (int q = 0; q < 8; ++q) { const f32x4 y = (v[q] * r) * A[q] + Sh[q]; v2u w; w.x = pk2(y.x, y.y); w.y = pk2(y.z, y.w); o[64 * q] = w; }
        if (!hn) break;
#pragma unroll
        for (int q = 0; q < 8; ++q) v[q] = vn[q];
        m = mn;
    }
}
__device__ __forceinline__ void phase_final_norm(float* X, const float* slab, const float* gate, const float* gamma, float* out, int vcu, int G, int wave, int lane) {
    const bool bal = slab != nullptr && G == 256; const int nr = norm_rows(bal, vcu, wave);
    int m = norm_row(bal, vcu, G, wave, 0); if (m >= MT) return;
    f32x4 v[8], Gm[8];
#pragma unroll
    for (int q = 0; q < 8; ++q) Gm[q] = ((const f32x4*)gamma + lane)[64 * q];
    load_row(X, X + (size_t)MP * DM, slab, gate, X, m, lane, v);
#pragma unroll 1
    for (int i = 0; i < nr; ++i) {
        const int mn = (i + 1 < nr) ? norm_row(bal, vcu, G, wave, i + 1) : MT; const bool hn = mn < MT;
        f32x4 vn[8];
#pragma unroll
        for (int q = 0; q < 8; ++q) vn[q] = v[q];
        if (hn) load_row(X, X + (size_t)MP * DM, nullptr, gate, X, mn, lane, vn);
        float ss = 0.f;
#pragma unroll
        for (int q = 0; q < 8; ++q) ss += (v[q].x * v[q].x + v[q].y * v[q].y) + (v[q].z * v[q].z + v[q].w * v[q].w);
        const float r = 1.0f / sqrtf(wave_sum(ss, lane) * (1.0f / DM) + EPS);
        f32x4* o = (f32x4*)(out + (size_t)m * DM) + lane;
#pragma unroll
        for (int q = 0; q < 8; ++q) o[64 * q] = (v[q] * r) * Gm[q];
        if (!hn) break;
#pragma unroll
        for (int q = 0; q < 8; ++q) v[q] = vn[q];
        m = mn;
    }
}

constexpr int LDT = 136;
__device__ __forceinline__ void rot16(const bf16* src  , const f32x2* rope  , int d0, float scale, float (&o1)[16], float (&o2)[16]) {
    const v4u a0 = *(const v4u*)(src + d0), a1 = *(const v4u*)(src + d0 + 8), b0 = *(const v4u*)(src + 64 + d0), b1 = *(const v4u*)(src + 64 + d0 + 8);
    const unsigned aw[8] = {a0.x, a0.y, a0.z, a0.w, a1.x, a1.y, a1.z, a1.w}, bw[8] = {b0.x, b0.y, b0.z, b0.w, b1.x, b1.y, b1.z, b1.w};
#pragma unroll
    for (int i = 0; i < 16; ++i) { const float x1 = (i & 1) ? bfhi(aw[i >> 1]) : bflo(aw[i >> 1]), x2 = (i & 1) ? bfhi(bw[i >> 1]) : bflo(bw[i >> 1]);
        const f32x2 cs = rope[d0 + i]; o1[i] = (x1 * cs.x - x2 * cs.y) * scale; o2[i] = (x1 * cs.y + x2 * cs.x) * scale; }
}
__device__ __forceinline__ void kv_item(const bf16* PROJ, const f32x2* ROPEP, float* KV, LAS unsigned char* lds, int item, int tid, int wave, int lane) {
    const int h = item & 7, n = (item >> 3) & 15, b = item >> 7;
    LAS bf16* KT = (LAS bf16*)lds; LAS bf16* VT = KT + 128 * LDT;
    const int tok = tid & 127, s = tid >> 7; const int row = b * PSEQ + n * 128 + tok;
    const bf16* prow = PROJ + (size_t)row * DIN;
    const float lg = ret_lg(h);
    { float o1[16], o2[16]; rot16(prow + C_K + h * HD, ROPEP + (size_t)(n * 128 + tok) * 64, 16 * s, 0.08838834764831845f * __expf((float)(127 - tok) * lg), o1, o2);
#pragma unroll
      for (int i = 0; i < 16; ++i) { KT[(16 * s + i) * LDT + tok] = (bf16)f2bf(o1[i]); KT[(64 + 16 * s + i) * LDT + tok] = (bf16)f2bf(o2[i]); } }
    { const bf16* vp = prow + C_V + h * HD + 32 * s;
#pragma unroll
      for (int q = 0; q < 4; ++q) { const v4u w = *(const v4u*)(vp + 8 * q); const unsigned ww[4] = {w.x, w.y, w.z, w.w};
#pragma unroll
          for (int i = 0; i < 4; ++i) { VT[(32 * s + 8 * q + 2 * i) * LDT + tok] = (bf16)(ww[i] & 0xffffu); VT[(32 * s + 8 * q + 2 * i + 1) * LDT + tok] = (bf16)(ww[i] >> 16); } } }
    __syncthreads();
    const int j = lane & 15, kg = lane >> 4;
    f32x4 acc[8];
#pragma unroll
    for (int cb = 0; cb < 8; ++cb) acc[cb] = (f32x4){0.f, 0.f, 0.f, 0.f};
#pragma unroll
    for (int ks = 0; ks < 4; ++ks) { const bf16x8 X = *(const LAS bf16x8*)(VT + (16 * wave + j) * LDT + 32 * ks + 8 * kg);
#pragma unroll
        for (int cb = 0; cb < 8; ++cb) { const bf16x8 Y = *(const LAS bf16x8*)(KT + (16 * cb + j) * LDT + 32 * ks + 8 * kg); acc[cb] = MFMA16(X, Y, acc[cb]); } }
    SETTLE8(acc);
    float* kvo = KV + (size_t)((b * NH + h) * NCHUNK + n) * 128 * 128;
#pragma unroll
    for (int cb = 0; cb < 8; ++cb)
#pragma unroll
        for (int r = 0; r < 4; ++r) kvo[(size_t)(16 * wave + 4 * kg + r) * 128 + 16 * cb + j] = acc[cb][r];
    __syncthreads();
}

constexpr int DRV_LD = 20;
constexpr int SSM_WREG = 128 * DRV_LD * 4;
constexpr int HS_LD = 136;
constexpr int YA_LD = 520;
template <int PASS>
__device__ __forceinline__ void ssm_block(const Args& a, unsigned char* ws, int l, int blk  , LAS unsigned char* lds, int wave, int lane) {
    const bf16* PROJ = (const bf16*)(ws + WS_R1 + R1_PROJ);
    const f32x2* AB = (const f32x2*)(ws + WS_SAB) + (size_t)l * NG * NST; const bf16* BB = (const bf16*)(ws + WS_SBB) + (size_t)l * NG * 128 * 16; const bf16* CM = (const bf16*)(ws + WS_SCM) + (size_t)l * NG * 16 * 128;
    const int row0 = blk * 32; const bool sample = row0 >= MP;
    LAS float* DRV = (LAS float*)(lds + wave * SSM_WREG);
    LAS bf16* YA = (LAS bf16*)(lds + NWAVES * SSM_WREG);
    const int j = lane & 15, kg = lane >> 4, p = lane;
    const float* dsk = a.in[20] + (size_t)l * D_SSM;
#pragma unroll 1
    for (int gi = 0; gi < 4; ++gi) {
        const int g = wave * 4 + gi;
        bf16x8 Yb[8], Yc[4];
#pragma unroll
        for (int cb = 0; cb < 8; ++cb) { Yb[cb] = (bf16x8){0, 0, 0, 0, 0, 0, 0, 0}; if (kg < 2) Yb[cb] = *(const bf16x8*)(BB + ((size_t)g * 128 + 16 * cb + j) * 16 + 8 * kg); }
        if (PASS == 2) {
#pragma unroll
            for (int ks = 0; ks < 4; ++ks) Yc[ks] = *(const bf16x8*)(CM + ((size_t)g * 16 + j) * 128 + 32 * ks + 8 * kg);
        }
        const f32x2 ab = AB[g * NST + p];
        const float dk = (PASS == 2) ? dsk[g * 16 + j] : 0.f;
        float hr = 0.f, hi = 0.f;
        if (PASS == 2 && !sample) { const int b = row0 >> 11, bk = (row0 & 2047) >> 5; const f32x2 hin = ((const f32x2*)(ws + WS_HIN))[((size_t)(b * NBLK + bk) * NG + g) * NST + p]; hr = hin.x; hi = hin.y; }
        bf16x8 Xn = (bf16x8){0, 0, 0, 0, 0, 0, 0, 0}; if (kg < 2) Xn = *(const bf16x8*)(PROJ + (size_t)(row0 + j) * DIN + C_UA + g * 16 + 8 * kg);
#pragma unroll 1
        for (int sub = 0; sub < 2; ++sub) {
            const int r0 = row0 + 16 * sub;
            const bf16x8 X = Xn;
            if (sub == 0) { Xn = (bf16x8){0, 0, 0, 0, 0, 0, 0, 0}; if (kg < 2) Xn = *(const bf16x8*)(PROJ + (size_t)(row0 + 16 + j) * DIN + C_UA + g * 16 + 8 * kg); }
            float us[4] = {0.f, 0.f, 0.f, 0.f}; float h0r[2] = {0.f, 0.f}, h0i[2] = {0.f, 0.f};
            if (PASS == 2) {
#pragma unroll
                for (int r = 0; r < 4; ++r) us[r] = bf2f(PROJ[(size_t)(r0 + 4 * kg + r) * DIN + C_UA + g * 16 + j]);
                if (sample) {
#pragma unroll
                    for (int q = 0; q < 2; ++q) { const int seq = ((r0 - MP) >> 3) + q; const size_t si = (((size_t)l * SB + seq) * NG + g) * NST + p; h0r[q] = a.in[2][si]; h0i[q] = a.in[3][si]; } }
            }
            f32x4 dd[8];
#pragma unroll
            for (int cb = 0; cb < 8; ++cb) dd[cb] = MFMA16(X, Yb[cb], ((f32x4){0.f, 0.f, 0.f, 0.f}));
            SETTLE8(dd);
#pragma unroll
            for (int cb = 0; cb < 8; ++cb) *(LAS f32x4*)(DRV + (16 * cb + j) * DRV_LD + 4 * kg) = dd[cb];
            CFENCE();
            float dr[16], di[16];
#pragma unroll
            for (int t4 = 0; t4 < 4; ++t4) { const f32x4 vr = *(const LAS f32x4*)(DRV + p * DRV_LD + 4 * t4), vi = *(const LAS f32x4*)(DRV + (64 + p) * DRV_LD + 4 * t4);
                dr[4 * t4] = vr.x; dr[4 * t4 + 1] = vr.y; dr[4 * t4 + 2] = vr.z; dr[4 * t4 + 3] = vr.w; di[4 * t4] = vi.x; di[4 * t4 + 1] = vi.y; di[4 * t4 + 2] = vi.z; di[4 * t4 + 3] = vi.w; }
            CFENCE();
#pragma unroll
            for (int t = 0; t < 16; ++t) {
                if (PASS == 2 && sample && (t & 7) == 0) { hr = h0r[t >> 3]; hi = h0i[t >> 3]; }
                const float nr = ab.x * hr - ab.y * hi + dr[t], ni = ab.x * hi + ab.y * hr + di[t]; hr = nr; hi = ni;
                if (PASS == 2) { LAS bf16* hb = (LAS bf16*)DRV + t * HS_LD; { const unsigned hw = pk2(hr, hi); hb[p] = (bf16)(hw & 0xffffu); hb[64 + p] = (bf16)(hw >> 16); }
                    if (sample && (t & 7) == 7) { const int seq = (r0 + t - MP) >> 3; const size_t si = (((size_t)l * SB + seq) * NG + g) * NST + p; a.out[O_SRE + si] = hr; a.out[O_SIM + si] = hi; } }
            }
            if (PASS == 2) {
                CFENCE();
                f32x4 y = (f32x4){0.f, 0.f, 0.f, 0.f};
#pragma unroll
                for (int ks = 0; ks < 4; ++ks) { const bf16x8 Xh = *(const LAS bf16x8*)((LAS bf16*)DRV + j * HS_LD + 32 * ks + 8 * kg); y = MFMA16(Xh, Yc[ks], y); }
                SETTLE1(y);
#pragma unroll
                for (int r = 0; r < 4; ++r) YA[(16 * sub + 4 * kg + r) * YA_LD + g * 16 + j] = (bf16)f2bf(gelu_tanh(y[r] + dk * us[r]));
                CFENCE();
            }
        }
        if (PASS == 1) { const int b = row0 >> 11, bk = (row0 & 2047) >> 5; ((f32x2*)(ws + WS_E))[((size_t)(b * NBLK + bk) * NG + g) * NST + p] = (f32x2){hr, hi}; }
    }
}

__device__ __forceinline__ void sret_item(const Args& a, unsigned char* ws, int l, int item, LAS unsigned char* lds, int tid, int wave, int lane) {
    const bf16* PROJ = (const bf16*)(ws + WS_R1 + R1_PROJ); bf16* MIX = (bf16*)(ws + WS_R1 + R1_MIX); const f32x2* ROPES = (const f32x2*)(ws + WS_ROPES);
    const int h = item & 7, b = item >> 3; const int rowb = MP + b * SSEQ;
    LAS float* QS = (LAS float*)lds;
    LAS float* KS = QS + 1024;
    LAS float* QR = KS + 1024;
    LAS float* KR = QR + 1024;
    LAS float* VS = KR + 1024;
    LAS float* SCS = VS + 1024;
    LAS float* ORED = SCS + 64;
    const float lg = ret_lg(h);
    { const int t = tid >> 6, d = tid & 63; const bf16* pr = PROJ + (size_t)(rowb + t) * DIN; const f32x2 cs = ROPES[t * 64 + d];
      const float q1 = bf2f(pr[C_Q + h * HD + d]), q2 = bf2f(pr[C_Q + h * HD + 64 + d]), k1 = bf2f(pr[C_K + h * HD + d]), k2 = bf2f(pr[C_K + h * HD + 64 + d]);
      const float qa = q1 * cs.x - q2 * cs.y, qb = q1 * cs.y + q2 * cs.x, ka = (k1 * cs.x - k2 * cs.y) * 0.08838834764831845f, kb = (k1 * cs.y + k2 * cs.x) * 0.08838834764831845f;
      const float qd = __expf((float)(t + 1) * lg), kd = __expf((float)(7 - t) * lg);
      QS[d * 8 + t] = qa * qd; QS[(64 + d) * 8 + t] = qb * qd; KS[d * 8 + t] = ka * kd; KS[(64 + d) * 8 + t] = kb * kd;
      QR[t * 128 + d] = qa; QR[t * 128 + 64 + d] = qb; KR[t * 128 + d] = ka; KR[t * 128 + 64 + d] = kb;
      const unsigned vw = *(const unsigned*)(pr + C_V + h * HD + 2 * d); VS[t * 128 + 2 * d] = bflo(vw); VS[t * 128 + 2 * d + 1] = bfhi(vw); }
    __syncthreads();
    if (tid < 64) { const int i = tid >> 3, jj = tid & 7; float s = 0.f;
        for (int d = 0; d < 128; ++d) s += QR[i * 128 + d] * KR[jj * 128 + d];
        SCS[tid] = (i >= jj) ? s * __expf((float)(i - jj) * lg) : 0.f; }
    const int e4 = tid & 31, dg = tid >> 5;
    f32x4 vv[8];
#pragma unroll
    for (int t = 0; t < 8; ++t) vv[t] = *(const LAS f32x4*)(VS + t * 128 + 4 * e4);
    f32x4 oacc[8];
#pragma unroll
    for (int t = 0; t < 8; ++t) oacc[t] = (f32x4){0.f, 0.f, 0.f, 0.f};
    const float cdec = __expf(8.0f * lg);
    const float* S0 = a.in[4] + ((size_t)(l * SB + b) * NH + h) * HD * HD; float* S1 = a.out + O_SRET + ((size_t)(l * SB + b) * NH + h) * HD * HD;
    f32x4 s4[8];
#pragma unroll
    for (int r = 0; r < 8; ++r) s4[r] = *(const f32x4*)(S0 + (size_t)(dg + 16 * r) * HD + 4 * e4);
#pragma unroll
    for (int r = 0; r < 8; ++r) { const int d = dg + 16 * r;
        const f32x4 qa = *(const LAS f32x4*)(QS + d * 8), qb = *(const LAS f32x4*)(QS + d * 8 + 4), ka = *(const LAS f32x4*)(KS + d * 8), kb = *(const LAS f32x4*)(KS + d * 8 + 4);
        const float qq[8] = {qa.x, qa.y, qa.z, qa.w, qb.x, qb.y, qb.z, qb.w}, kk[8] = {ka.x, ka.y, ka.z, ka.w, kb.x, kb.y, kb.z, kb.w};
        f32x4 sn = s4[r] * cdec;
#pragma unroll
        for (int t = 0; t < 8; ++t) { oacc[t] += s4[r] * qq[t]; sn += vv[t] * kk[t]; }
        *(f32x4*)(S1 + (size_t)d * HD + 4 * e4) = sn; }
#pragma unroll
    for (int t = 0; t < 8; ++t) *(LAS f32x4*)(ORED + (dg * 8 + t) * 128 + 4 * e4) = oacc[t];
    __syncthreads();
    { const int t = wave, e0 = 2 * lane; float o0 = 0.f, o1 = 0.f;
#pragma unroll
      for (int q = 0; q < 16; ++q) { const f32x2 v = *(const LAS f32x2*)(ORED + (q * 8 + t) * 128 + e0); o0 += v.x; o1 += v.y; }
#pragma unroll
      for (int jj = 0; jj < 8; ++jj) { const float sc = SCS[t * 8 + jj]; o0 += sc * VS[jj * 128 + e0]; o1 += sc * VS[jj * 128 + e0 + 1]; }
      const float mu = wave_sum(o0 + o1, lane) * (1.0f / 128.0f); const float d0 = o0 - mu, d1 = o1 - mu; const float var = wave_sum(d0 * d0 + d1 * d1, lane) * (1.0f / 128.0f); const float rs = 1.0f / sqrtf(var + EPS);
      const unsigned gw_ = *(const unsigned*)(PROJ + (size_t)(rowb + t) * DIN + C_G + h * HD + e0);
      *(unsigned*)(MIX + (size_t)(rowb + t) * DM + D_SSM + h * HD + e0) = pk2(d0 * rs * fsilu(bflo(gw_)), d1 * rs * fsilu(bfhi(gw_))); }
    __syncthreads();
}

__device__ __forceinline__ void phase_mixA2(const Args& a, unsigned char* ws, int l, int vcu, int G, int tid) {
    const int gt = vcu * NTHR + tid, NT = G * NTHR;
    const float* KV = (const float*)(ws + WS_R1 + R1_KV); bf16* SPT = (bf16*)(ws + WS_R1 + R1_SPT);
    for (int i = gt; i < PB * NH * 128 * 16; i += NT) { const int d8 = i & 15, e = (i >> 4) & 127, bh = i >> 11; const int h = bh & 7;
        const float cdec = __expf(128.0f * ret_lg(h)); float S[8];
#pragma unroll
        for (int q = 0; q < 8; ++q) S[q] = 0.f;
#pragma unroll 1
        for (int nb = 0; nb < NCHUNK; nb += 8) {
            f32x4 k0[8], k1[8];
#pragma unroll
            for (int n = 0; n < 8; ++n) { const float* kp = KV + (size_t)(bh * NCHUNK + nb + n) * 128 * 128 + (size_t)e * 128 + 8 * d8; k0[n] = *(const f32x4*)kp; k1[n] = *(const f32x4*)(kp + 4); }
#pragma unroll
            for (int n = 0; n < 8; ++n) { const size_t base = (size_t)(bh * NCHUNK + nb + n) * 128 * 128;
                v4u w; w.x = pk2(S[0], S[1]); w.y = pk2(S[2], S[3]); w.z = pk2(S[4], S[5]); w.w = pk2(S[6], S[7]);
                *(v4u*)(SPT + base + (size_t)e * 128 + 8 * d8) = w;
                S[0] = cdec * S[0] + k0[n].x; S[1] = cdec * S[1] + k0[n].y; S[2] = cdec * S[2] + k0[n].z; S[3] = cdec * S[3] + k0[n].w;
                S[4] = cdec * S[4] + k1[n].x; S[5] = cdec * S[5] + k1[n].y; S[6] = cdec * S[6] + k1[n].z; S[7] = cdec * S[7] + k1[n].w; } }
        float* po = a.out + O_PRET + ((size_t)l * PB * NH + bh) * HD * HD;
#pragma unroll
        for (int q = 0; q < 8; ++q) po[(size_t)(8 * d8 + q) * HD + e] = S[q]; }
    const f32x2* A32 = (const f32x2*)(ws + WS_SA32) + (size_t)l * NG * NST; const f32x2* E = (const f32x2*)(ws + WS_E); f32x2* HIN = (f32x2*)(ws + WS_HIN);
    for (int i = gt - (NT - PB * NG * NST); i >= 0 && i < PB * NG * NST; i += NT) { const int gp = i & (NG * NST - 1), b = i >> 11; const f32x2 aa = A32[gp]; float hr = 0.f, hi = 0.f;
#pragma unroll 1
        for (int kb = 0; kb < NBLK; kb += 32) {
            f32x2 ev[32];
#pragma unroll
            for (int k = 0; k < 32; ++k) ev[k] = E[(size_t)(b * NBLK + kb + k) * NG * NST + gp];
#pragma unroll
            for (int k = 0; k < 32; ++k) { HIN[(size_t)(b * NBLK + kb + k) * NG * NST + gp] = (f32x2){hr, hi};
                const float nr = aa.x * hr - aa.y * hi + ev[k].x, ni = aa.x * hi + aa.y * hr + ev[k].y; hr = nr; hi = ni; } }
        a.out[O_PRE + ((size_t)l * PB + b) * NG * NST + gp] = hr; a.out[O_PIM + ((size_t)l * PB + b) * NG * NST + gp] = hi; }
}

__device__ __forceinline__ void rope8(const v4u a, const v4u b, const f32x4 (&cs)[4], float scale, float (&r1)[8], float (&r2)[8]) {
    const unsigned aw[4] = {a.x, a.y, a.z, a.w}, bw[4] = {b.x, b.y, b.z, b.w};
#pragma unroll
    for (int i = 0; i < 8; ++i) { const float x1 = (i & 1) ? bfhi(aw[i >> 1]) : bflo(aw[i >> 1]), x2 = (i & 1) ? bfhi(bw[i >> 1]) : bflo(bw[i >> 1]);
        const float c = (i & 1) ? cs[i >> 1].z : cs[i >> 1].x, sn = (i & 1) ? cs[i >> 1].w : cs[i >> 1].y;
        r1[i] = (x1 * c - x2 * sn) * scale; r2[i] = (x1 * sn + x2 * c) * scale; }
}
__device__ __forceinline__ v4u pk8(const float (&r)[8]) { v4u w; w.x = pk2(r[0], r[1]); w.y = pk2(r[2], r[3]); w.z = pk2(r[4], r[5]); w.w = pk2(r[6], r[7]); return w; }
__device__ __forceinline__ void ret_item(const Args& a, unsigned char* ws, int item, LAS unsigned char* lds, int tid, int wave, int lane) {
    const bf16* PROJ = (const bf16*)(ws + WS_R1 + R1_PROJ); bf16* MIX = (bf16*)(ws + WS_R1 + R1_MIX); const f32x2* ROPEP = (const f32x2*)(ws + WS_ROPEP);
    const bf16* SPT = (const bf16*)(ws + WS_R1 + R1_SPT);
    const int h = item & 7, n = (item >> 3) & 15, b = item >> 7;
    LAS bf16* KS = (LAS bf16*)lds; LAS bf16* VT = KS + 128 * LDT; LAS bf16* SCW = VT + 128 * LDT + wave * 16 * LDT;
    const float lg = ret_lg(h);
    const int j = lane & 15, kg = lane >> 4;
    const int tok = tid & 127, s = tid >> 7; const bf16* prow = PROJ + (size_t)(b * PSEQ + n * 128 + tok) * DIN;
    const bf16* ksrc = prow + C_K + h * HD + 16 * s; const f32x4* krp = (const f32x4*)(ROPEP + (size_t)(n * 128 + tok) * 64 + 16 * s);
    const v4u ka0 = *(const v4u*)ksrc, ka1 = *(const v4u*)(ksrc + 8), kb0 = *(const v4u*)(ksrc + 64), kb1 = *(const v4u*)(ksrc + 72);
    f32x4 kc0[4], kc1[4];
#pragma unroll
    for (int i = 0; i < 4; ++i) { kc0[i] = krp[i]; kc1[i] = krp[4 + i]; }
    v4u vw[4];
#pragma unroll
    for (int q = 0; q < 4; ++q) vw[q] = *(const v4u*)(prow + C_V + h * HD + 32 * s + 8 * q);
    const int rowi = b * PSEQ + n * 128 + 16 * wave + j;
    const bf16* qp = PROJ + (size_t)rowi * DIN + C_Q + h * HD + 8 * kg; const f32x4* qrp = (const f32x4*)(ROPEP + (size_t)(n * 128 + 16 * wave + j) * 64 + 8 * kg);
    const v4u qa0 = *(const v4u*)qp, qa1 = *(const v4u*)(qp + 32), qb0 = *(const v4u*)(qp + 64), qb1 = *(const v4u*)(qp + 96);
    f32x4 qc0[4], qc1[4];
#pragma unroll
    for (int i = 0; i < 4; ++i) { qc0[i] = qrp[i]; qc1[i] = qrp[16 + i]; }
    const int gr = lane >> 2, gc = lane & 3;
    const size_t orow = (size_t)b * PSEQ + n * 128 + 16 * wave + gr;
    v4u gt[4];
#pragma unroll
    for (int i = 0; i < 4; ++i) gt[i] = *(const v4u*)(PROJ + orow * DIN + C_G + h * HD + 32 * gc + 8 * i);
    { float r1[8], r2[8];
      rope8(ka0, kb0, kc0, 0.08838834764831845f, r1, r2); *(LAS v4u*)(KS + tok * LDT + 16 * s) = pk8(r1); *(LAS v4u*)(KS + tok * LDT + 64 + 16 * s) = pk8(r2);
      rope8(ka1, kb1, kc1, 0.08838834764831845f, r1, r2); *(LAS v4u*)(KS + tok * LDT + 16 * s + 8) = pk8(r1); *(LAS v4u*)(KS + tok * LDT + 64 + 16 * s + 8) = pk8(r2);
#pragma unroll
      for (int q = 0; q < 4; ++q) { const unsigned ww[4] = {vw[q].x, vw[q].y, vw[q].z, vw[q].w};
#pragma unroll
          for (int i = 0; i < 4; ++i) { VT[(32 * s + 8 * q + 2 * i) * LDT + tok] = (bf16)(ww[i] & 0xffffu); VT[(32 * s + 8 * q + 2 * i + 1) * LDT + tok] = (bf16)(ww[i] >> 16); } } }
    bf16x8 XQ[4];
    { float r1[8], r2[8];
      rope8(qa0, qb0, qc0, 1.0f, r1, r2); XQ[0] = __builtin_bit_cast(bf16x8, pk8(r1)); XQ[2] = __builtin_bit_cast(bf16x8, pk8(r2));
      rope8(qa1, qb1, qc1, 1.0f, r1, r2); XQ[1] = __builtin_bit_cast(bf16x8, pk8(r1)); XQ[3] = __builtin_bit_cast(bf16x8, pk8(r2)); }
    __syncthreads();
    const bf16* spt = SPT + (size_t)((b * NH + h) * NCHUNK + n) * 128 * 128 + (size_t)j * 128 + 8 * kg;
    bf16x8 Ys[4][8];
#pragma unroll
    for (int ks = 0; ks < 2; ++ks)
#pragma unroll
        for (int eb = 0; eb < 8; ++eb) Ys[ks][eb] = *(const bf16x8*)(spt + (size_t)(16 * eb) * 128 + 32 * ks);
#pragma unroll
    for (int jb = 0; jb < 8; ++jb) { f32x4 sc = (f32x4){0.f, 0.f, 0.f, 0.f};
#pragma unroll
        for (int ks = 0; ks < 4; ++ks) { const bf16x8 Y = *(const LAS bf16x8*)(KS + (16 * jb + j) * LDT + 32 * ks + 8 * kg); sc = MFMA16(XQ[ks], Y, sc); }
        SETTLE1(sc);
#pragma unroll
        for (int r = 0; r < 4; ++r) { const int ii = 16 * wave + 4 * kg + r, jj = 16 * jb + j; const float m = (ii >= jj) ? __expf((float)(ii - jj) * lg) : 0.f; SCW[(4 * kg + r) * LDT + jj] = (bf16)f2bf(sc[r] * m); } }
    CFENCE();
#pragma unroll
    for (int ks = 2; ks < 4; ++ks)
#pragma unroll
        for (int eb = 0; eb < 8; ++eb) Ys[ks][eb] = *(const bf16x8*)(spt + (size_t)(16 * eb) * 128 + 32 * ks);
    f32x4 oi[8], ox[8];
#pragma unroll
    for (int eb = 0; eb < 8; ++eb) { oi[eb] = (f32x4){0.f, 0.f, 0.f, 0.f}; ox[eb] = (f32x4){0.f, 0.f, 0.f, 0.f}; }
#pragma unroll
    for (int ks = 0; ks < 4; ++ks) { const bf16x8 Xs = *(const LAS bf16x8*)(SCW + j * LDT + 32 * ks + 8 * kg);
#pragma unroll
        for (int eb = 0; eb < 8; ++eb) { const bf16x8 Yv = *(const LAS bf16x8*)(VT + (16 * eb + j) * LDT + 32 * ks + 8 * kg); oi[eb] = MFMA16(Xs, Yv, oi[eb]); } }
#pragma unroll
    for (int ks = 0; ks < 4; ++ks)
#pragma unroll
        for (int eb = 0; eb < 8; ++eb) ox[eb] = MFMA16(XQ[ks], Ys[ks][eb], ox[eb]);
    SETTLE8(oi); SETTLE8(ox);
    CFENCE();
#pragma unroll
    for (int r = 0; r < 4; ++r) { const int ii = 16 * wave + 4 * kg + r; const float qd = __expf((float)(ii + 1) * lg);
        float o[8]; float sm = 0.f;
#pragma unroll
        for (int eb = 0; eb < 8; ++eb) { o[eb] = oi[eb][r] + qd * ox[eb][r]; sm += o[eb]; }
        const float mu = sum16(sm, lane) * (1.0f / 128.0f); float q = 0.f;
#pragma unroll
        for (int eb = 0; eb < 8; ++eb) { o[eb] -= mu; q += o[eb] * o[eb]; }
        const float rs = 1.0f / sqrtf(sum16(q, lane) * (1.0f / 128.0f) + EPS);
#pragma unroll
        for (int eb = 0; eb < 8; ++eb) SCW[(4 * kg + r) * LDT + 16 * eb + j] = (bf16)f2bf(o[eb] * rs); }
    CFENCE();
#pragma unroll
    for (int i = 0; i < 4; ++i) { const v4u nv = *(const LAS v4u*)(SCW + gr * LDT + 32 * gc + 8 * i); const unsigned nw[4] = {nv.x, nv.y, nv.z, nv.w}, gw[4] = {gt[i].x, gt[i].y, gt[i].z, gt[i].w}; v4u ow; unsigned o4[4];
#pragma unroll
        for (int q = 0; q < 4; ++q) o4[q] = pk2(bflo(nw[q]) * fsilu(bflo(gw[q])), bfhi(nw[q]) * fsilu(bfhi(gw[q])));
        ow.x = o4[0]; ow.y = o4[1]; ow.z = o4[2]; ow.w = o4[3];
        *(v4u*)(MIX + orow * DM + D_SSM + h * HD + 32 * gc + 8 * i) = ow; }
    __syncthreads();
}

template <int W, int NOUT> __device__ __forceinline__ void pool_vals(const float (&val)[15 + NOUT], int pos0, bool prompt, LAS bf16* pl  ) {
#pragma unroll
    for (int i = 0; i < NOUT; ++i) { float s = 0.f;
#pragma unroll
        for (int q = W - 1; q >= 0; --q) s += val[15 + i - q];
        const int pc = pos0 + i + 1; const float m = (prompt && pc < W) ? s / (float)pc : s * (1.0f / (float)W); pl[i * YA_LD] = (bf16)f2bf(m - val[15 + i]); }
}
template <int PARTS  >
__device__ __forceinline__ void tok_item(const Args& a, unsigned char* ws, int l, int blk, LAS unsigned char* lds, int tid, int wave, int lane) {
    const bf16* PROJ = (const bf16*)(ws + WS_R1 + R1_PROJ); bf16* MIX = (bf16*)(ws + WS_R1 + R1_MIX);
    const bf16* wl = (const bf16*)(ws + WS_W + (size_t)l * W_LAYER);
    const int row0 = blk * 32; const bool sample = row0 >= MP;
    if (PARTS & 1) ssm_block<2>(a, ws, l, blk, lds, wave, lane);
    __syncthreads();
    LAS bf16* YA = (LAS bf16*)(lds + NWAVES * SSM_WREG);
    const int j = lane & 15, kg = lane >> 4;
    if (PARTS & 2) {
      const bf16* WG = (const bf16*)((const char*)wl + W_GLU);
      f32x4 acc[2][4];
#pragma unroll
      for (int rb = 0; rb < 2; ++rb)
#pragma unroll
          for (int cb = 0; cb < 4; ++cb) acc[rb][cb] = (f32x4){0.f, 0.f, 0.f, 0.f};
      const bf16* wgp = WG + (size_t)(64 * wave + j) * D_SSM + 8 * kg;
#define GLU_LOAD(Yd, kb) do { _Pragma("unroll") for (int q = 0; q < 4; ++q) _Pragma("unroll") for (int cb = 0; cb < 4; ++cb) Yd[q][cb] = *(const bf16x8*)(wgp + (size_t)(16 * cb) * D_SSM + 32 * (4 * (kb) + q)); } while (0)
#define GLU_MMA(Yd, kb) do { _Pragma("unroll") for (int q = 0; q < 4; ++q) { bf16x8 X[2]; _Pragma("unroll") for (int rb = 0; rb < 2; ++rb) X[rb] = *(const LAS bf16x8*)(YA + (16 * rb + j) * YA_LD + 32 * (4 * (kb) + q) + 8 * kg); \
          _Pragma("unroll") for (int cb = 0; cb < 4; ++cb) _Pragma("unroll") for (int rb = 0; rb < 2; ++rb) acc[rb][cb] = MFMA16(X[rb], Yd[q][cb], acc[rb][cb]); } } while (0)
      bf16x8 Y0[4][4], Y1[4][4];
      GLU_LOAD(Y0, 0); GLU_LOAD(Y1, 1); GLU_MMA(Y0, 0); GLU_LOAD(Y0, 2); GLU_MMA(Y1, 1); GLU_LOAD(Y1, 3); GLU_MMA(Y0, 2); GLU_MMA(Y1, 3);
#undef GLU_LOAD
#undef GLU_MMA
      SETTLE4(acc[0][0], acc[0][1], acc[0][2], acc[0][3]); SETTLE4(acc[1][0], acc[1][1], acc[1][2], acc[1][3]);
      const float* bg = a.in[22] + (size_t)l * D_SSM;
#pragma unroll
      for (int cb = 0; cb < 4; ++cb) { const int col = 64 * wave + 16 * cb + j; const float bias = bg[col];
#pragma unroll
          for (int rb = 0; rb < 2; ++rb)
#pragma unroll
              for (int r = 0; r < 4; ++r) { const int tk = 16 * rb + 4 * kg + r; const float ya = bf2f(YA[tk * YA_LD + col]); MIX[(size_t)(row0 + tk) * DM + col] = (bf16)f2bf(ya * fsigmoid(acc[rb][cb][r] + bias)); } } }
    __syncthreads();
    LAS bf16* PL = YA;
    if (PARTS & 4) { const int c = tid; const int gi = c >> 7;
      if (!sample) { const int b = row0 >> 11, t0 = row0 & 2047; float val[47];
#pragma unroll
          for (int k = 0; k < 47; ++k) { const int t = t0 - 15 + k; val[k] = (t >= 0) ? bf2f(PROJ[(size_t)(b * PSEQ + t) * DIN + C_UC + c]) : 0.f; }
          if (gi == 0) pool_vals<2, 32>(val, t0, true, PL + c); else if (gi == 1) pool_vals<4, 32>(val, t0, true, PL + c); else if (gi == 2) pool_vals<8, 32>(val, t0, true, PL + c); else pool_vals<16, 32>(val, t0, true, PL + c);
          if (t0 == PSEQ - 32) { float* po = a.out + O_PPOOL + ((size_t)(l * PB + b) * 15) * D_POOL + c;
#pragma unroll
              for (int q = 0; q < 15; ++q) po[(size_t)q * D_POOL] = val[32 + q]; }
      } else {
#pragma unroll 1
          for (int sq = 0; sq < 4; ++sq) { const int seq = ((row0 - MP) >> 3) + sq; float val[23];
              const float* sp = a.in[5] + ((size_t)(l * SB + seq) * 15) * D_POOL + c;
#pragma unroll
              for (int k = 0; k < 15; ++k) val[k] = sp[(size_t)k * D_POOL];
#pragma unroll
              for (int k = 0; k < 8; ++k) val[15 + k] = bf2f(PROJ[(size_t)(MP + seq * 8 + k) * DIN + C_UC + c]);
              LAS bf16* pls = PL + (8 * sq) * YA_LD + c;
              if (gi == 0) pool_vals<2, 8>(val, 0, false, pls); else if (gi == 1) pool_vals<4, 8>(val, 0, false, pls); else if (gi == 2) pool_vals<8, 8>(val, 0, false, pls); else pool_vals<16, 8>(val, 0, false, pls);
              float* po = a.out + O_SPOOL + ((size_t)(l * SB + seq) * 15) * D_POOL + c;
#pragma unroll
              for (int q = 0; q < 15; ++q) po[(size_t)q * D_POOL] = val[8 + q]; }
      } }
    __syncthreads();
#if DBG_CHECK
    { bf16* PLD = (bf16*)(ws + WS_END); for (int i = 0; i < 32; ++i) PLD[(size_t)(row0 + i) * D_POOL + tid] = PL[i * YA_LD + tid]; }
#endif
    if (PARTS & 4) {
      const int gi = wave >> 1, dh = wave & 1; const bf16* WP = (const bf16*)((const char*)wl + W_POOL) + (size_t)gi * 128 * 128;
      f32x4 acc[2][4];
#pragma unroll
      for (int rb = 0; rb < 2; ++rb)
#pragma unroll
          for (int cb = 0; cb < 4; ++cb) acc[rb][cb] = (f32x4){0.f, 0.f, 0.f, 0.f};
#pragma unroll
      for (int ks = 0; ks < 4; ++ks) { bf16x8 X[2];
#pragma unroll
          for (int rb = 0; rb < 2; ++rb) X[rb] = *(const LAS bf16x8*)(PL + (16 * rb + j) * YA_LD + gi * 128 + 32 * ks + 8 * kg);
#pragma unroll
          for (int cb = 0; cb < 4; ++cb) { const bf16x8 Y = *(const bf16x8*)(WP + (size_t)(64 * dh + 16 * cb + j) * 128 + 32 * ks + 8 * kg);
#pragma unroll
              for (int rb = 0; rb < 2; ++rb) acc[rb][cb] = MFMA16(X[rb], Y, acc[rb][cb]); } }
      SETTLE4(acc[0][0], acc[0][1], acc[0][2], acc[0][3]); SETTLE4(acc[1][0], acc[1][1], acc[1][2], acc[1][3]);
      const float* psc = a.in[24] + (size_t)l * D_POOL;
#pragma unroll
      for (int cb = 0; cb < 4; ++cb) { const int dcol = gi * 128 + 64 * dh + 16 * cb + j; const float sc = psc[dcol];
#pragma unroll
          for (int rb = 0; rb < 2; ++rb)
#pragma unroll
              for (int r = 0; r < 4; ++r) { const int tk = 16 * rb + 4 * kg + r; MIX[(size_t)(row0 + tk) * DM + D_SSM + D_RET + dcol] = (bf16)f2bf(acc[rb][cb][r] * sc); } } }
    __syncthreads();
}
__device__ __forceinline__ void phase_mixA(const Args& a, unsigned char* ws, int l, LAS unsigned char* lds, int vcu, int G, int tid, int wave, int, int qrep = 0) {
    const bf16* PROJ = (const bf16*)(ws + WS_R1 + R1_PROJ);
    constexpr int N_KV = PB * NCHUNK * NH, N_S1 = MP / 32, N_SR = SB * NH, N_TS = 2 * (MS / 32);
    const int tid_in = tid;
    unsigned* const qctr = (unsigned*)(ws + 8192) + 64 * (2 * l + 4 * qrep);
    volatile LAS int* const qslot = (volatile LAS int*)(lds + MISC_OFF + 64);
    (void)vcu; (void)G;
    for (;;) {
        int tid = tid_in; asm volatile("" : "+v"(tid)); const int lane = tid & 63;
        if (tid == 0) *qslot = (int)atomicAdd(qctr, 1u);
        __syncthreads();
        const int it = __builtin_amdgcn_readfirstlane(*qslot);
        if (it >= N_TS + N_KV + N_S1 + N_SR) break;
        if (it < N_TS / 2) tok_item<3>(a, ws, l, MP / 32 + it, lds, tid, wave, lane);
        else if (it < N_TS) tok_item<4>(a, ws, l, MP / 32 + it - N_TS / 2, lds, tid, wave, lane);
        else if (it < N_TS + N_KV) kv_item(PROJ, (const f32x2*)(ws + WS_ROPEP), (float*)(ws + WS_R1 + R1_KV), lds, it - N_TS, tid, wave, lane);
        else if (it < N_TS + N_KV + N_S1) { ssm_block<1>(a, ws, l, it - N_TS - N_KV, lds, wave, lane); __syncthreads(); }
        else sret_item(a, ws, l, it - N_TS - N_KV - N_S1, lds, tid, wave, lane);
    }
}

__device__ __forceinline__ void phase_mixB(const Args& a, unsigned char* ws, int l, LAS unsigned char* lds, int vcu, int G, int tid, int wave, int, int qrep = 0) {
    constexpr int N_R = PB * NCHUNK * NH, N_T = MP / 32;
    const int tid_in = tid;
    unsigned* const qctr = (unsigned*)(ws + 8192) + 64 * (2 * l + 1 + 4 * qrep);
    volatile LAS int* const qslot = (volatile LAS int*)(lds + MISC_OFF + 64);
    (void)vcu; (void)G;
    for (;;) {
        int tid = tid_in; asm volatile("" : "+v"(tid)); const int lane = tid & 63;
        if (tid == 0) *qslot = (int)atomicAdd(qctr, 1u);
        __syncthreads();
        const int it = __builtin_amdgcn_readfirstlane(*qslot);
        if (it >= N_R + N_T) break;
#ifndef SUBSEL
#define SUBSEL 3
#endif
        if (it < N_T) { if (SUBSEL & 2) tok_item<7>(a, ws, l, N_T - 1 - it, lds, tid, wave, lane); }
        else { if (SUBSEL & 1) ret_item(a, ws, it - N_T, lds, tid, wave, lane); }
    }
}

constexpr size_t WS_SLAB3 = WS_END, WS_HALO = WS_SLAB3 + (size_t)8 * 3072 * 256 * 4, WS_FIXA = WS_HALO + (size_t)64 * 2 * FF * 4, WS_FIXB = WS_FIXA + (size_t)64 * 2 * FF * 4, WS_END2 = WS_FIXB + (size_t)64 * 2 * FF * 4;
__device__ __forceinline__ void ld8(const float* p, float (&v)[8]) { const f32x4 x = *(const f32x4*)p, y = *(const f32x4*)(p + 4); v[0] = x.x; v[1] = x.y; v[2] = x.z; v[3] = x.w; v[4] = y.x; v[5] = y.y; v[6] = y.z; v[7] = y.w; }
__device__ __forceinline__ void slab_ab(const float* slab, int row, int sc, float (&av)[8], float (&bv)[8]) {
    f32x4 a0 = (f32x4){0.f, 0.f, 0.f, 0.f}, a1 = a0, b0 = a0, b1 = a0;
#pragma unroll
    for (int p = 0; p < 8; ++p) { const float* sp = slab + ((size_t)p * 3072 + (row - 6144)) * 256 + sc; a0 += *(const f32x4*)sp; a1 += *(const f32x4*)(sp + 4); b0 += *(const f32x4*)(sp + 128); b1 += *(const f32x4*)(sp + 132); }
    av[0] = a0.x; av[1] = a0.y; av[2] = a0.z; av[3] = a0.w; av[4] = a1.x; av[5] = a1.y; av[6] = a1.z; av[7] = a1.w; bv[0] = b0.x; bv[1] = b0.y; bv[2] = b0.z; bv[3] = b0.w; bv[4] = b1.x; bv[5] = b1.y; bv[6] = b1.z; bv[7] = b1.w;
}
__device__ __forceinline__ void act8(const float (&w0)[8], const float (&w1)[8], const float (&w2)[8], const float (&bb)[8], const float (&p2)[8], const float (&p1)[8], const float (&av)[8], const float (&bv)[8], bf16* dst) {
    float o[8];
#pragma unroll
    for (int q = 0; q < 8; ++q) o[q] = fsilu(bb[q] + w0[q] * p2[q] + w1[q] * p1[q] + w2[q] * av[q]) * bv[q];
    v4u w; w.x = pk2(o[0], o[1]); w.y = pk2(o[2], o[3]); w.z = pk2(o[4], o[5]); w.w = pk2(o[6], o[7]); *(v4u*)dst = w;
}
__device__ __forceinline__ void phase_actfix(const Args& a, unsigned char* ws, int l, int vcu, int G, int tid) {
    bf16* ACT = (bf16*)(ws + WS_ACT); const float* slab = (const float*)(ws + WS_SLAB3); const float* HALO = (const float*)(ws + WS_HALO); const float* FIXA = (const float*)(ws + WS_FIXA); const float* FIXB = (const float*)(ws + WS_FIXB);
    const float* cw = a.in[28] + (size_t)l * 3 * FF; const float* cbias = a.in[29] + (size_t)l * FF;
    const int gt = vcu * NTHR + tid, NT = G * NTHR; constexpr int NCG = FF / 8;
    for (int i = gt; i < 64 * 2 * NCG; i += NT) { const int cg = i % NCG, j = (i / NCG) & 1, blk = i / (2 * NCG), c0 = 8 * cg;
        if ((blk & 15) == 0 || (TAILSPLIT && c0 >= 42 * 128 && blk >= 48)) continue;
        float w0[8], w1[8], w2[8], bb[8], av[8], bv[8], p1[8], p2[8];
        ld8(cw + c0, w0); ld8(cw + FF + c0, w1); ld8(cw + 2 * FF + c0, w2); ld8(cbias + c0, bb);
        ld8(FIXA + ((size_t)blk * 2 + j) * FF + c0, av); ld8(FIXB + ((size_t)blk * 2 + j) * FF + c0, bv);
        if (j == 0) { ld8(HALO + ((size_t)(blk - 1) * 2 + 0) * FF + c0, p2); ld8(HALO + ((size_t)(blk - 1) * 2 + 1) * FF + c0, p1); }
        else { ld8(HALO + ((size_t)(blk - 1) * 2 + 1) * FF + c0, p2); ld8(FIXA + ((size_t)blk * 2 + 0) * FF + c0, p1); }
        act8(w0, w1, w2, bb, p2, p1, av, bv, ACT + (size_t)(128 * blk + j) * FF + c0); }
    for (int i = gt - (NT - PB * 2 * FF); i >= 0 && i < PB * 2 * FF; i += NT) { const int c = i % FF, j = (i / FF) & 1, b = i / (2 * FF); if (TAILSPLIT && c >= 42 * 128 && b == 3) continue;
        a.out[O_PCONV + ((size_t)(l * PB + b) * 2 + j) * FF + c] = HALO[((size_t)(16 * b + 15) * 2 + j) * FF + c]; }
    for (int i = gt; i < (TAILSPLIT ? 768 * 16 : 0); i += NT) { const int cg16 = i & 15, run4 = i >> 4, row0 = 6144 + 4 * run4, sc = 8 * cg16, c0 = 42 * 128 + sc; const bool sample = row0 >= MP;
        float w0[8], w1[8], w2[8], bb[8], av[8], bv[8], p1[8], p2[8], dm[8];
        ld8(cw + c0, w0); ld8(cw + FF + c0, w1); ld8(cw + 2 * FF + c0, w2); ld8(cbias + c0, bb);
        if (sample && (row0 & 7) == 0) { const int seq = (row0 - MP) >> 3; ld8(a.in[6] + ((size_t)(l * SB + seq) * 2 + 0) * FF + c0, p2); ld8(a.in[6] + ((size_t)(l * SB + seq) * 2 + 1) * FF + c0, p1); }
        else if (!sample && (row0 & 2047) == 0) {
#pragma unroll
            for (int q = 0; q < 8; ++q) { p1[q] = 0.f; p2[q] = 0.f; } }
        else { slab_ab(slab, row0 - 2, sc, p2, dm); slab_ab(slab, row0 - 1, sc, p1, dm); }
#pragma unroll 1
        for (int t = 0; t < 4; ++t) { const int row = row0 + t; slab_ab(slab, row, sc, av, bv);
            act8(w0, w1, w2, bb, p2, p1, av, bv, ACT + (size_t)row * FF + c0);
            if (sample) { if ((row & 7) >= 6) { float* so = a.out + O_SCONV + ((size_t)(l * SB + ((row - MP) >> 3)) * 2 + ((row & 7) - 6)) * FF + c0;
#pragma unroll
                    for (int q = 0; q < 8; ++q) so[q] = av[q]; } }
            else if ((row & 2047) >= PSEQ - 2) { float* po = a.out + O_PCONV + ((size_t)(l * PB + (row >> 11)) * 2 + ((row & 2047) - (PSEQ - 2))) * FF + c0;
#pragma unroll
                for (int q = 0; q < 8; ++q) po[q] = av[q]; }
#pragma unroll
            for (int q = 0; q < 8; ++q) { p2[q] = p1[q]; p1[q] = av[q]; } } }
}

__device__ __forceinline__ void phase_act(const Args& a, unsigned char* ws, int l, int vcu, int G, int tid) {
    const bf16* AB = (const bf16*)(ws + WS_R1); bf16* ACT = (bf16*)(ws + WS_ACT);
    const float* cw = a.in[28] + (size_t)l * 3 * FF; const float* cbias = a.in[29] + (size_t)l * FF;
    const int gt = vcu * NTHR + tid, NT = G * NTHR; constexpr int NCG = FF / 8;
    for (int i = gt; i < (MT / 32) * NCG; i += NT) {
        const int run = i / NCG, cg = i % NCG, c0 = 8 * cg; const int acol = 256 * (c0 >> 7) + (c0 & 127); const int row0 = run * 32;
        float w0[8], w1[8], w2[8], bb[8];
#pragma unroll
        for (int q = 0; q < 8; ++q) { w0[q] = cw[c0 + q]; w1[q] = cw[FF + c0 + q]; w2[q] = cw[2 * FF + c0 + q]; bb[q] = cbias[c0 + q]; }
        float am1[8], am2[8];
        const bool sample = row0 >= MP;
#pragma unroll
        for (int q = 0; q < 8; ++q) { am1[q] = 0.f; am2[q] = 0.f; }
        if (!sample && (row0 & 2047) != 0) { const v4u p1 = *(const v4u*)(AB + (size_t)(row0 - 1) * 2 * FF + acol), p2 = *(const v4u*)(AB + (size_t)(row0 - 2) * 2 * FF + acol);
            const unsigned u1[4] = {p1.x, p1.y, p1.z, p1.w}, u2[4] = {p2.x, p2.y, p2.z, p2.w};
#pragma unroll
            for (int q = 0; q < 4; ++q) { am1[2 * q] = bflo(u1[q]); am1[2 * q + 1] = bfhi(u1[q]); am2[2 * q] = bflo(u2[q]); am2[2 * q + 1] = bfhi(u2[q]); } }
#pragma unroll 4
        for (int t = 0; t < 32; ++t) { const int row = row0 + t;
            if (sample && (t & 7) == 0) { const int seq = (row - MP) >> 3; const float* st = a.in[6] + ((size_t)(l * SB + seq) * 2) * FF + c0;
#pragma unroll
                for (int q = 0; q < 8; ++q) { am2[q] = st[q]; am1[q] = st[FF + q]; } }
            const v4u av = *(const v4u*)(AB + (size_t)row * 2 * FF + acol), bv = *(const v4u*)(AB + (size_t)row * 2 * FF + acol + 128);
            const unsigned ua[4] = {av.x, av.y, av.z, av.w}, ub[4] = {bv.x, bv.y, bv.z, bv.w}; float o[8], ac[8];
#pragma unroll
            for (int q = 0; q < 8; ++q) { ac[q] = (q & 1) ? bfhi(ua[q >> 1]) : bflo(ua[q >> 1]); const float bq = (q & 1) ? bfhi(ub[q >> 1]) : bflo(ub[q >> 1]);
                const float cv = bb[q] + w0[q] * am2[q] + w1[q] * am1[q] + w2[q] * ac[q]; o[q] = fsilu(cv) * bq; am2[q] = am1[q]; am1[q] = ac[q]; }
            v4u w; w.x = pk2(o[0], o[1]); w.y = pk2(o[2], o[3]); w.z = pk2(o[4], o[5]); w.w = pk2(o[6], o[7]); *(v4u*)(ACT + (size_t)row * FF + c0) = w;
            if (sample) { if ((t & 7) >= 6) { const int seq = (row - MP) >> 3; float* so = a.out + O_SCONV + ((size_t)(l * SB + seq) * 2 + ((t & 7) - 6)) * FF + c0;
#pragma unroll
                    for (int q = 0; q < 8; ++q) so[q] = ac[q]; } }
            else if ((row & 2047) >= PSEQ - 2) { const int b = row >> 11; float* po = a.out + O_PCONV + ((size_t)(l * PB + b) * 2 + ((row & 2047) - (PSEQ - 2))) * FF + c0;
#pragma unroll
                for (int q = 0; q < 8; ++q) po[q] = ac[q]; }
        }
    }
}


#ifndef DBG_CHECK
#define DBG_CHECK 0
#endif
#if DBG_CHECK
__device__ __forceinline__ float bfr(float x) { return bf2f(f2bf(x)); }
__device__ __forceinline__ bool dbg_bad(float fast, float ref, float rtol, float atol) { const float d = fabsf(fast - ref); return !(d <= rtol * fabsf(ref) + atol); }
__device__ __forceinline__ void dbg_report(unsigned char* ws, LAS unsigned* cnt, int nbad, int bit, int thr, int tid) {
    if (nbad) atomicAdd((unsigned*)cnt, (unsigned)nbad);
    __syncthreads();
    if (tid == 0) { if ((int)cnt[0] >= thr) atomicOr((unsigned*)(ws + 2048), 1u << bit); atomicAdd((unsigned*)(ws + 2048 + 64 * (bit + 1)), cnt[0]); cnt[0] = 0u; }
    __syncthreads();
}
__device__ __forceinline__ void phase_dbgA(const Args& a, unsigned char* ws, int l, LAS unsigned char* lds, int bx, int G, int tid, int wave, int lane) {
    const bf16* PROJ = (const bf16*)(ws + WS_R1 + R1_PROJ); const bf16* MIX = (const bf16*)(ws + WS_R1 + R1_MIX); const bf16* H = (const bf16*)(ws + WS_H);
    LAS float* F = (LAS float*)lds;
    LAS unsigned* cnt = (LAS unsigned*)(lds + 120000);
    if (tid == 0) cnt[0] = 0u;
    __syncthreads();
    for (int rr = 0; rr < 3; ++rr) {
        const int row = (bx * 3 + rr) * 12 % MT;
        const int col = (tid * 10 + (bx % 10)) % DIN;
        const float* w = a.in[12] + (size_t)l * DM * DIN + col; const bf16* hr = H + (size_t)row * DM; float s = 0.f;
        for (int k = 0; k < DM; ++k) s += bf2f(hr[k]) * bfr(w[(size_t)k * DIN]);
        const int bad = dbg_bad(bf2f(PROJ[(size_t)row * DIN + col]), s, 0.02f, 0.02f) ? 1 : 0;
        dbg_report(ws, cnt, bad & 0, 0, 1, tid);
    }
    for (int rr = 0; rr < 8; ++rr) {
        const int row = ((bx * 8 + rr) * 131 + 5 * (rr & 1)) % MT; const bool sample = row >= MP;
        const int c = tid, gi = c >> 7, W = 2 << gi; float sum = 0.f, self = 0.f; int cntw = W;
        if (!sample) { const int b = row >> 11, t = row & 2047; for (int s_ = 0; s_ < W; ++s_) { const int tt = t - s_; if (tt >= 0) sum += bf2f(PROJ[(size_t)(b * PSEQ + tt) * DIN + C_UC + c]); } self = bf2f(PROJ[(size_t)row * DIN + C_UC + c]); cntw = (t + 1 < W) ? t + 1 : W; }
        else { const int seq = (row - MP) >> 3, t = (row - MP) & 7; for (int s_ = 0; s_ < W; ++s_) { const int tt = t - s_; sum += (tt >= 0) ? bf2f(PROJ[(size_t)(MP + seq * 8 + tt) * DIN + C_UC + c]) : a.in[5][((size_t)(l * SB + seq) * 15 + (15 + tt)) * D_POOL + c]; } self = bf2f(PROJ[(size_t)row * DIN + C_UC + c]); }
        F[c] = bfr(sum / (float)cntw - self);
        { const bf16* PLD = (const bf16*)(ws + WS_END); const float pf = bf2f(PLD[(size_t)row * D_POOL + c]); if (!sample && dbg_bad(pf, F[c], 0.01f, 0.01f)) atomicAdd((unsigned*)(ws + 2048 + 64 * 3), 1u); }
        __syncthreads();
        const int d = tid & 127; const float* wp = a.in[23] + ((size_t)l * 4 + gi) * 128 * 128; float m = 0.f;
        for (int cc = 0; cc < 128; ++cc) m += F[gi * 128 + cc] * bfr(wp[(size_t)cc * 128 + d]);
        m *= a.in[24][(size_t)l * D_POOL + gi * 128 + d];
        const int bad = dbg_bad(bf2f(MIX[(size_t)row * DM + D_SSM + D_RET + gi * 128 + d]), m, 0.03f, 0.03f) ? 1 : 0;
        dbg_report(ws, cnt, bad, sample ? 1 : 0, 2, tid);
    }
    for (int rr = 0; rr < 4; ++rr) {
        const int row = ((bx * 4 + rr) * 131 + (rr & 1)) % MT; const bool sample = row >= MP; const int h = (row * 7 + bx) & 7; const float lg = ret_lg(h);
        LAS float* QF = F; LAS float* SJ = F + 128; LAS float* OP = F + 128 + 2048;
        const int b = sample ? (row - MP) >> 3 : row >> 11, t = sample ? (row - MP) & 7 : row & 2047;
        const int rbase = sample ? MP + b * 8 : b * PSEQ;
        const f32x2* rope = sample ? (const f32x2*)(ws + WS_ROPES) : (const f32x2*)(ws + WS_ROPEP);
        if (tid < 64) { const bf16* qp = PROJ + (size_t)row * DIN + C_Q + h * HD; const f32x2 cs = rope[t * 64 + tid]; const float x1 = bf2f(qp[tid]), x2 = bf2f(qp[64 + tid]); QF[tid] = x1 * cs.x - x2 * cs.y; QF[64 + tid] = x1 * cs.y + x2 * cs.x; }
        __syncthreads();
        for (int jx = tid; jx <= t; jx += NTHR) { const bf16* kp = PROJ + (size_t)(rbase + jx) * DIN + C_K + h * HD; float s = 0.f;
            for (int d = 0; d < 64; ++d) { const f32x2 cs = rope[jx * 64 + d]; const float x1 = bf2f(kp[d]), x2 = bf2f(kp[64 + d]); s += QF[d] * (x1 * cs.x - x2 * cs.y) + QF[64 + d] * (x1 * cs.y + x2 * cs.x); }
            SJ[jx] = s * 0.08838834764831845f * expf((float)(t - jx) * lg); }
        __syncthreads();
        { const int e = tid & 127, part = tid >> 7; float o = 0.f;
          for (int jx = part; jx <= t; jx += 4) o += SJ[jx] * bf2f(PROJ[(size_t)(rbase + jx) * DIN + C_V + h * HD + e]);
          if (sample && part == 0) { const float* S0 = a.in[4] + ((size_t)(l * SB + b) * NH + h) * HD * HD; float cx = 0.f; for (int d = 0; d < 128; ++d) cx += QF[d] * S0[(size_t)d * HD + e]; o += cx * expf((float)(t + 1) * lg); }
          OP[part * 128 + e] = o; }
        __syncthreads();
        if (tid < 128) { OP[tid] = OP[tid] + OP[128 + tid] + OP[256 + tid] + OP[384 + tid]; }
        __syncthreads();
        if (tid < 128) { float mu = 0.f; for (int e = 0; e < 128; ++e) mu += OP[e]; mu *= (1.0f / 128.0f); float var = 0.f; for (int e = 0; e < 128; ++e) { const float dlt = OP[e] - mu; var += dlt * dlt; } var *= (1.0f / 128.0f);
            const float y = (OP[tid] - mu) / sqrtf(var + EPS) * fsilu(bf2f(PROJ[(size_t)row * DIN + C_G + h * HD + tid]));
            const int bad = dbg_bad(bf2f(MIX[(size_t)row * DM + D_SSM + h * HD + tid]), y, 0.05f, 0.05f) ? 1 : 0;
            if (bad) atomicAdd((unsigned*)cnt, 1u); }
        dbg_report(ws, cnt, 0, sample ? 6 : 7, 3, tid);
    }
    for (int rr = 0; rr < 2; ++rr) {
        const int rsel = bx * 2 + rr; const bool sample = (rsel & 7) == 7; const int row = sample ? MP + (rsel * 37) % MS : ((rsel & 3) * PSEQ + (rsel * 29) % 600);
        const int b = sample ? (row - MP) >> 3 : row >> 11, t = sample ? (row - MP) & 7 : row & 2047; const int rbase = sample ? MP + b * 8 : b * PSEQ;
        LAS float* HR = F; LAS float* HI = F + 2048; LAS float* YAF = F + 4096;
        float ar[4], ai[4], hr_[4], hi_[4];
        const bf16* BBt = (const bf16*)(ws + WS_SBB) + (size_t)l * NG * 128 * 16;
#pragma unroll
        for (int q = 0; q < 4; ++q) { const int gp = tid * 4 + q; const f32x2 ab = ((const f32x2*)(ws + WS_SAB))[(size_t)l * NG * NST + gp]; ar[q] = ab.x; ai[q] = ab.y;
            if (sample) { const size_t si = ((size_t)(l * SB + b) * NG) * NST + gp; hr_[q] = a.in[2][si]; hi_[q] = a.in[3][si]; } else { hr_[q] = 0.f; hi_[q] = 0.f; } }
#pragma unroll 1
        for (int s_ = 0; s_ <= t; ++s_) {
#pragma unroll
            for (int q = 0; q < 4; ++q) { const int gp = tid * 4 + q, g = gp >> 6, p = gp & 63; const bf16* up = PROJ + (size_t)(rbase + s_) * DIN + C_UA + g * 16; float dr = 0.f, di = 0.f;
                const bf16* br_ = BBt + ((size_t)g * 128 + p) * 16; const bf16* bi_ = BBt + ((size_t)g * 128 + 64 + p) * 16;
#pragma unroll
                for (int ch = 0; ch < 16; ++ch) { const float u = bf2f(up[ch]); dr += bf2f(br_[ch]) * u; di += bf2f(bi_[ch]) * u; }
                const float nr = ar[q] * hr_[q] - ai[q] * hi_[q] + dr, ni = ar[q] * hi_[q] + ai[q] * hr_[q] + di; hr_[q] = nr; hi_[q] = ni; } }
#pragma unroll
        for (int q = 0; q < 4; ++q) { HR[tid * 4 + q] = hr_[q]; HI[tid * 4 + q] = hi_[q]; }
        __syncthreads();
        { const int k = tid, g = k >> 4, ch = k & 15; const size_t ci = ((size_t)(l * NG + g) * 16 + ch) * 64; float y = 0.f;
          for (int p = 0; p < 64; ++p) y += bfr(a.in[18][ci + p]) * bfr(HR[g * 64 + p]) - bfr(a.in[19][ci + p]) * bfr(HI[g * 64 + p]);
          y += a.in[20][(size_t)l * D_SSM + k] * bf2f(PROJ[(size_t)row * DIN + C_UA + k]); YAF[k] = bfr(gelu_tanh(y)); }
        __syncthreads();
        { const int n = tid; float z = a.in[22][(size_t)l * D_SSM + n]; const float* wg = a.in[21] + (size_t)l * D_SSM * D_SSM + n;
          for (int k = 0; k < 512; ++k) z += YAF[k] * bfr(wg[(size_t)k * D_SSM]);
          const float o = YAF[n] * fsigmoid(z);
          const int bad = dbg_bad(bf2f(MIX[(size_t)row * DM + n]), o, 0.05f, 0.04f) ? 1 : 0;
          dbg_report(ws, cnt, bad & 0, 3, 3, tid); }
    }
}
#endif

#if DBG_CHECK
__device__ __forceinline__ float dbg_dot(const bf16* h, const bf16* w) { float s = 0.f;
#pragma unroll 4
    for (int k = 0; k < DM; ++k) s += bf2f(h[k]) * bf2f(w[k]); return s; }
__device__ __forceinline__ void phase_dbgB(const Args& a, unsigned char* ws, int l, LAS unsigned char* lds, int bx, int G, int tid) {
    unsigned long long z_ = 0; asm volatile("" : "+s"(z_));
    const bf16* H = (const bf16*)(ws + WS_H) + z_; const bf16* ACT = (const bf16*)(ws + WS_ACT) + z_; const bf16* WU = (const bf16*)(ws + WS_W + (size_t)l * W_LAYER + W_UP) + z_;
    const float* in6 = a.in[6] + z_; const float* in28 = a.in[28] + z_; const float* in29 = a.in[29] + z_;
    LAS unsigned* cnt = (LAS unsigned*)(lds + 120000); if (tid == 0) cnt[0] = 0u; __syncthreads();
    for (int rr = 0; rr < 6; ++rr) {
        int row; if (rr < 2) row = ((bx * 2 + rr) % 64) * 128 + (rr & 1) + ((bx >> 5) & 1) * 0; else row = ((bx * 4 + rr) * 131) % MT;
        if (rr < 2) row = ((bx & 63) * 128) + 8 * (1 + (bx >> 6)) + rr;
        const bool sample = row >= MP; const int t = sample ? (row - MP) & 7 : row & 2047;
        const int c = (tid * 10 + (bx % 10) + 3 * rr) % FF; const int wr_a = 256 * (c >> 7) + (c & 127), wr_b = wr_a + 128;
        const float a0 = dbg_dot(H + (size_t)row * DM, WU + (size_t)wr_a * DM), b0 = dbg_dot(H + (size_t)row * DM, WU + (size_t)wr_b * DM);
        float a1, a2;
        if (t >= 1) a1 = dbg_dot(H + (size_t)(row - 1) * DM, WU + (size_t)wr_a * DM); else a1 = sample ? in6[((size_t)(l * SB + ((row - MP) >> 3)) * 2 + 1) * FF + c] : 0.f;
        if (t >= 2) a2 = dbg_dot(H + (size_t)(row - 2) * DM, WU + (size_t)wr_a * DM); else a2 = sample ? in6[((size_t)(l * SB + ((row - MP) >> 3)) * 2 + t) * FF + c] : 0.f;
        const float* cw = in28 + (size_t)l * 3 * FF; const float cv = in29[(size_t)l * FF + c] + cw[c] * a2 + cw[FF + c] * a1 + cw[2 * FF + c] * a0;
        const float ref = fsilu(cv) * b0;
        const int bad = dbg_bad(bf2f(ACT[(size_t)row * FF + c]), ref, 0.03f, 0.02f) ? 1 : 0;
        dbg_report(ws, cnt, bad, sample ? 1 : ((row & 7) < 2 ? 0 : 2), 4, tid);
    }
}
#endif

#ifndef ONLY
#define ONLY -1
#endif
#define SEL(k) (ONLY < 0 || ONLY == (k))
#ifndef PROBE_REPQ
#define PROBE_REPQ -1
#endif
#ifndef PROBE_BAR2
#define PROBE_BAR2 0
#endif
#define REPQ(k) for (int rep_ = 0; rep_ < ((PROBE_REPQ == (k)) ? 2 : 1); ++rep_)
#ifndef GEMM_SP2
#define GEMM_SP2 (!DBG_CHECK)
#endif
constexpr int PH_PER_LAYER = 10, N_PHASES = 2 + DEPTH * PH_PER_LAYER + 1;
__global__ void __launch_bounds__(NTHR, 2) hyb_fwd(const float* i0, const float* i1, const float* i2, const float* i3, const float* i4, const float* i5, const float* i6, const float* i7, const float* i8, const float* i9, const float* i10, const float* i11, const float* i12, const float* i13, const float* i14, const float* i15, const float* i16, const float* i17, const float* i18, const float* i19, const float* i20, const float* i21, const float* i22, const float* i23, const float* i24, const float* i25, const float* i26, const float* i27, const float* i28, const float* i29, const float* i30, const float* i31, float* outp, unsigned char* wsp, int ph_lo_, int ph_hi_) {
    Args args; args.in[0] = i0; args.in[1] = i1; args.in[2] = i2; args.in[3] = i3; args.in[4] = i4; args.in[5] = i5; args.in[6] = i6; args.in[7] = i7; args.in[8] = i8; args.in[9] = i9; args.in[10] = i10; args.in[11] = i11; args.in[12] = i12; args.in[13] = i13; args.in[14] = i14; args.in[15] = i15; args.in[16] = i16; args.in[17] = i17; args.in[18] = i18; args.in[19] = i19; args.in[20] = i20; args.in[21] = i21; args.in[22] = i22; args.in[23] = i23; args.in[24] = i24; args.in[25] = i25; args.in[26] = i26; args.in[27] = i27; args.in[28] = i28; args.in[29] = i29; args.in[30] = i30; args.in[31] = i31; args.out = outp; args.ws = wsp; args.ph_lo = ph_lo_; args.ph_hi = ph_hi_;
    extern __shared__ __attribute__((aligned(16))) unsigned char lds_raw[];
    LAS unsigned char* lds = (LAS unsigned char*)lds_raw;
    const int tid = threadIdx.x, lane = tid & 63, wave = __builtin_amdgcn_readfirstlane(tid >> 6);
    const int G = gridDim.x; const int bx = blockIdx.x; const int vcu = (G % 8 == 0) ? (bx % 8) * (G / 8) + bx / 8 : bx;
    unsigned char* ws = args.ws;
    for (int u = tid; u < (LDS_BYTES - LDSCTL_OFF) / 4; u += NTHR) ((LAS unsigned*)(lds + LDSCTL_OFF))[u] = 0u;
    __syncthreads();
    const int lo = args.ph_lo, hi = args.ph_hi;
    XcdBarrier bar; bar.bar = (unsigned*)(ws + WS_CTL) + CW_BAR; bar.x = 0; bar.st = nullptr;
    if (hi - lo > 1) bar = xcd_barrier_post((unsigned*)(ws + WS_CTL) + CW_BAR, (volatile LAS unsigned*)(lds + MISC_OFF) + 8);
    unsigned char* const ws0 = ws; int wave0_ = wave; asm volatile("" : "+s"(wave0_)); const int wave0 = wave0_;
    for (int ph = lo; ph < hi; ++ph) {
#define GRIDBAR() do { int ln_; asm volatile("v_mbcnt_lo_u32_b32 %0, -1, 0\n\tv_mbcnt_hi_u32_b32 %0, -1, %0" : "=v"(ln_)); xcd_barrier(bar, (wave0 * 64 + ln_) == 0); } while (0)
#define FRESH() int lane; asm volatile("v_mbcnt_lo_u32_b32 %0, -1, 0\n\tv_mbcnt_hi_u32_b32 %0, -1, %0" : "=v"(lane)); const int tid = wave0 * 64 + lane; const int wave = wave0; (void)tid; (void)wave
        unsigned long long wsl = (unsigned long long)ws0; asm volatile("" : "+s"(wsl)); unsigned char* ws = (unsigned char*)(GAS unsigned char*)wsl;
        float* X = (float*)(ws + WS_X); bf16* H = (bf16*)(ws + WS_H); const float* MOD = (const float*)(ws + WS_MOD);
        bf16* PROJ = (bf16*)(ws + WS_R1 + R1_PROJ); bf16* MIX = (bf16*)(ws + WS_R1 + R1_MIX); bf16* ABb = (bf16*)(ws + WS_R1); bf16* ACT = (bf16*)(ws + WS_ACT);
        float* SLAB = (float*)(ws + WS_R1);
        if (ph == 0) { if (SEL(100)) REPQ(100) { FRESH(); phase_p0a(args, ws, lds, vcu, G, tid, wave, lane); } }
        else if (ph == 1) { if (SEL(101)) REPQ(101) { FRESH(); phase_p0b(args, ws, lds, vcu, G, tid, wave, lane); } }
        else if (ph == N_PHASES - 1) { if (SEL(102)) { FRESH(); phase_final_norm(X, SLAB, MOD + (size_t)(DEPTH - 1) * NCOND * NMOD + 5 * DM, args.in[31], args.out + O_YP, vcu, G, wave, lane); } }
        else {
            const int l = (ph - 2) / PH_PER_LAYER, q = (ph - 2) % PH_PER_LAYER;
            const float* modl = MOD + (size_t)l * NCOND * NMOD; const bf16* wl = (const bf16*)(ws + WS_W + (size_t)l * W_LAYER);
            const float* xp = (l == 0) ? args.in[0] : X; const float* xs = (l == 0) ? args.in[1] : X + (size_t)MP * DM;
            if (q == 0) { if (SEL(0)) REPQ(0) { FRESH(); phase_norm(xp, xs, (l == 0 || rep_) ? (const float*)nullptr : (const float*)SLAB, modl - (size_t)NCOND * NMOD + 5 * DM, X, args.in[11] + (size_t)l * DM, modl, 0, DM, H, vcu, G, wave, lane); } }
            else if (q == 1) { if (SEL(1)) REPQ(1) { FRESH(); pg8::Gemm g{H, (const bf16*)((const char*)wl + W_IN), MT, DIN, DM}; pg8::StaticOrder S; S.init(MT, DIN, DM, G, bx); pg8::EpiBf16 E{PROJ, DIN};
                pg8::gemm_phase<pg8::EpiBf16, pg8::StaticOrder, true, GEMM_SP2>(lds, g, S, E, tid);
                if (G == 256 && bx >= 208) { const int fw = (bx - 208) * NWAVES + wave;
                    if (l == 0) fill_range(args, ws, lds, 0, I_IN + I_OUT + I_UP3, I_UP4, fw, 48 * NWAVES, lane, wave); else if (l == 1) fill_range(args, ws, lds, 1, I_IN + I_OUT, I_UPH, fw, 48 * NWAVES, lane, wave); } } }
            else if (q == 2) { if (SEL(2)) REPQ(2) { FRESH(); phase_mixA(args, ws, l, lds, vcu, G, tid, wave, lane, rep_); } }
            else if (q == 3) { if (SEL(3)) REPQ(3) { FRESH(); phase_mixA2(args, ws, l, vcu, G, tid);
                if (G == 256 && vcu >= 128 && vcu < 240) { const int fw = (vcu - 128) * NWAVES + wave;
                    if (l == 0) fill_range(args, ws, lds, 0, I_IN, I_OUT + I_UP3, fw, 112 * NWAVES, lane, wave); else if (l == 1) fill_range(args, ws, lds, 1, I_IN + I_OUT + I_UPH, I_UP - I_UPH, fw, 112 * NWAVES, lane, wave); } } }
            else if (q == 4) { if (SEL(4)) REPQ(4) { FRESH(); phase_mixB(args, ws, l, lds, vcu, G, tid, wave, lane, rep_); } }
            else if (q == 5) { if (SEL(5)) { FRESH(); pg8::Gemm g{MIX, (const bf16*)((const char*)wl + W_OUT), MT, DM, DM}; pg8::SplitOrder S; S.init(DM, G, bx); pg8::EpiResid E{xp, xs, X, modl + 2 * DM, SLAB};
                pg8::gemm_phase<pg8::EpiResid, pg8::SplitOrder, true, GEMM_SP2>(lds, g, S, E, tid); } }
            else if (q == 6) { if (SEL(6)) REPQ(0) { FRESH(); phase_norm(X, rep_ ? X + (size_t)MP * DM : xs, rep_ ? (const float*)nullptr : (const float*)SLAB, modl + 2 * DM, X, args.in[26] + (size_t)l * DM, modl, 3 * DM, 4 * DM, H, vcu, G, wave, lane); } }
            else if (q == 7) { if (SEL(7)) REPQ(7) { FRESH(); pg8::Gemm g{H, (const bf16*)((const char*)wl + W_UP), MT, 2 * FF, DM}; pg8::TailOrder S; S.init(DM, G, bx);
                pg8::EpiAct E{ACT, args.in[28] + (size_t)l * 3 * FF, args.in[29] + (size_t)l * FF, args.in[6] + (size_t)l * SB * 2 * FF, args.out + O_SCONV + (size_t)l * SB * 2 * FF,
                              (float*)(ws + WS_HALO), (float*)(ws + WS_FIXA), (float*)(ws + WS_FIXB), (float*)(ws + WS_SLAB3)};
                pg8::gemm_phase<pg8::EpiAct, pg8::TailOrder, true, GEMM_SP2>(lds, g, S, E, tid);
                if (!TAILSPLIT && bx >= 12 && G == 256) { const int fw = (bx - 12) * NWAVES + wave, nfw = (G - 12) * NWAVES;
                    if (l == 0) { fill_range(args, ws, lds, 0, I_PRE, I_DOWN, fw, nfw, lane, wave); fill_range(args, ws, lds, 1, 0, I_IN + I_OUT, (fw + nfw - (I_DOWN % nfw)) % nfw, nfw, lane, wave); }
                    else if (l == 1) fill_range(args, ws, lds, 1, I_PRE, I_DOWN, fw, nfw, lane, wave); } } }
            else if (q == 8) { if (SEL(8)) { FRESH(); phase_actfix(args, ws, l, vcu, G, tid); }
            }
            else { if (SEL(9)) { FRESH(); pg8::Gemm g{ACT, (const bf16*)((const char*)wl + W_DOWN), MT, DM, FF}; pg8::SplitOrder S; S.init(FF, G, bx); pg8::EpiResid E{X, X + (size_t)MP * DM, X, modl + 5 * DM, SLAB};
                pg8::gemm_phase<pg8::EpiResid, pg8::SplitOrder, true, GEMM_SP2>(lds, g, S, E, tid); } }
        }
        if (ph + 1 < hi) { GRIDBAR(); if (PROBE_BAR2) GRIDBAR(); }
    }
}


#if DBG_CHECK
__global__ void __launch_bounds__(NTHR, 2) dbg_kernel(const float* in6, const float* in28, const float* in29, float* outp, unsigned char* wsp, int stage) {
    extern __shared__ __attribute__((aligned(16))) unsigned char lds_raw2[];
    LAS unsigned char* lds = (LAS unsigned char*)lds_raw2;
    Args a; for (int i = 0; i < 32; ++i) a.in[i] = nullptr; a.in[6] = in6; a.in[28] = in28; a.in[29] = in29; a.out = outp; a.ws = wsp; a.ph_lo = 0; a.ph_hi = 0;
    if (stage == 0) phase_dbgB(a, wsp, 0, lds, blockIdx.x, gridDim.x, threadIdx.x);
    else if (blockIdx.x == 0 && threadIdx.x == 0) { unsigned cs[3]; int bk[3]; for (int q = 0; q < 3; ++q) { cs[q] = ((unsigned*)(wsp + 2048 + 64 * (q + 1)))[0]; bk[q] = 0; for (unsigned t = cs[q]; t; t >>= 2) ++bk[q]; if (bk[q] > 5) bk[q] = 5; } outp[0] = 1000.0f * (float)(10 + bk[0] + 6 * bk[1] + 36 * bk[2]); }
}
#endif

extern "C" void kernel_launch(void* const* d_in, const int* in_sizes, int n_in, void* d_out, int out_size, void* d_ws, size_t ws_size, hipStream_t stream) {
    static int grid = 0;
    if (grid == 0) {
        if (n_in != 32 || (size_t)out_size != O_END || ws_size < WS_END2) { fprintf(stderr, "kernel_launch: shape mismatch: n_in %d out %d (want %zu) ws %zu (need %zu); nothing launched\n", n_in, out_size, (size_t)O_END, ws_size, (size_t)WS_END); grid = -1; return; }
        int dev = 0, cus = 0, per_cu = 0;
        if (hipGetDevice(&dev) != hipSuccess || hipDeviceGetAttribute(&cus, hipDeviceAttributeMultiprocessorCount, dev) != hipSuccess) { fprintf(stderr, "kernel_launch: device query failed\n"); grid = -1; return; }
        if (hipFuncSetAttribute((const void*)hyb_fwd, hipFuncAttributeMaxDynamicSharedMemorySize, LDS_BYTES) != hipSuccess) { fprintf(stderr, "kernel_launch: hipFuncSetAttribute failed\n"); grid = -1; return; }
        if (hipOccupancyMaxActiveBlocksPerMultiprocessor(&per_cu, (const void*)hyb_fwd, NTHR, LDS_BYTES) != hipSuccess || per_cu < 1) { fprintf(stderr, "kernel_launch: occupancy query reports %d blocks per CU\n", per_cu); per_cu = 1; }
        (void)hipGetLastError();
        grid = cus;
        if (grid < 256) { fprintf(stderr, "kernel_launch: this kernel's static schedules need 256 compute units, the device reports %d; nothing launched\n", grid); grid = -1; return; }
        grid = 256;
    }
    if (grid <= 0) return;
    (void)hipMemsetAsync((char*)d_ws + WS_CTL, 0, CTL_ZERO_BYTES, stream);
    Args a{};
    for (int i = 0; i < 32; ++i) a.in[i] = (const float*)d_in[i];
    a.out = (float*)d_out; a.ws = (unsigned char*)d_ws;
#if DBG_CHECK
    hipLaunchKernelGGL(hyb_fwd, dim3(grid), dim3(NTHR), LDS_BYTES, stream, a.in[0], a.in[1], a.in[2], a.in[3], a.in[4], a.in[5], a.in[6], a.in[7], a.in[8], a.in[9], a.in[10], a.in[11], a.in[12], a.in[13], a.in[14], a.in[15], a.in[16], a.in[17], a.in[18], a.in[19], a.in[20], a.in[21], a.in[22], a.in[23], a.in[24], a.in[25], a.in[26], a.in[27], a.in[28], a.in[29], a.in[30], a.in[31], a.out, a.ws, 0, 2 + 9);
    (void)hipFuncSetAttribute((const void*)dbg_kernel, hipFuncAttributeMaxDynamicSharedMemorySize, LDS_BYTES);
    hipLaunchKernelGGL(dbg_kernel, dim3(grid), dim3(NTHR), LDS_BYTES, stream, a.in[6], a.in[28], a.in[29], a.out, a.ws, 0);
    hipLaunchKernelGGL(dbg_kernel, dim3(1), dim3(NTHR), LDS_BYTES, stream, a.in[6], a.in[28], a.in[29], a.out, a.ws, 1);
    return;
#endif
#if MK_PER_PHASE
    for (int ph = 0; ph < N_PHASES; ++ph) { hipLaunchKernelGGL(hyb_fwd, dim3(grid), dim3(NTHR), LDS_BYTES, stream, a.in[0], a.in[1], a.in[2], a.in[3], a.in[4], a.in[5], a.in[6], a.in[7], a.in[8], a.in[9], a.in[10], a.in[11], a.in[12], a.in[13], a.in[14], a.in[15], a.in[16], a.in[17], a.in[18], a.in[19], a.in[20], a.in[21], a.in[22], a.in[23], a.in[24], a.in[25], a.in[26], a.in[27], a.in[28], a.in[29], a.in[30], a.in[31], a.out, a.ws, ph, ph + 1); }
#else
    hipLaunchKernelGGL(hyb_fwd, dim3(grid), dim3(NTHR), LDS_BYTES, stream, a.in[0], a.in[1], a.in[2], a.in[3], a.in[4], a.in[5], a.in[6], a.in[7], a.in[8], a.in[9], a.in[10], a.in[11], a.in[12], a.in[13], a.in[14], a.in[15], a.in[16], a.in[17], a.in[18], a.in[19], a.in[20], a.in[21], a.in[22], a.in[23], a.in[24], a.in[25], a.in[26], a.in[27], a.in[28], a.in[29], a.in[30], a.in[31], a.out, a.ws, 0, (int)N_PHASES);
#endif
}
```

```cpp
#include <hip/hip_runtime.h>
#include <cstdio>
#include <cstdint>

#ifndef MK_PER_PHASE
#define MK_PER_PHASE 0
#endif

namespace pg8 {
#define PG8_LAS __attribute__((address_space(3)))
typedef unsigned short bf16_t;
typedef short bf16x8 __attribute__((ext_vector_type(8)));
typedef float f32x4 __attribute__((ext_vector_type(4)));
typedef unsigned u32x4 __attribute__((ext_vector_type(4)));
constexpr int BM = 256, BK = 64, HALF = 128, HTB = HALF * BK * 2, STAGE_BYTES = 8 * HTB, NXCD = 8, WGM = 8;

__host__ __device__ __forceinline__ int lds_byte(int r, int c) { const int st = (r >> 4) * 2 + (c >> 5), rr = r & 15, cc = c & 31, ob = rr * 64 + cc * 2; return st * 1024 + (ob ^ (((ob >> 9) & 1) << 5)); }
__host__ __device__ __forceinline__ void stage_rc(int b, int& R, int& C) { const int st = b / 1024, sb = b % 1024, swz = sb ^ (((sb >> 9) & 1) << 5); R = (st >> 1) * 16 + swz / 64; C = (st & 1) * 32 + (swz % 64) / 2; }
__host__ __device__ __forceinline__ int perm32(int rho) { const int n = rho >> 4, i = rho & 15; return 8 * (i >> 2) + 4 * n + (i & 3); }

struct Unit { int pm, pn, k0, nt, part; };
struct Gemm { const bf16_t* A; const bf16_t* Bt; int M, N, K; };

struct StaticOrder {
    int nM, nN, nwg, G, c, ntk;
    __host__ __device__ void init(int M, int N, int K, int G_, int c_) { nM = M / BM; nN = N / BM; nwg = nM * nN; G = G_; c = c_; ntk = K / BK; }
    __host__ __device__ bool next(int i, Unit& u) const {
        const long L = (long)i * G + c; if (L >= nwg) return false;
        int wgid = (int)L; { const int q = nwg / NXCD, r = nwg % NXCD, xcd = wgid % NXCD, off = wgid / NXCD; wgid = (xcd < r ? xcd * (q + 1) : r * (q + 1) + (xcd - r) * q) + off; }
        const int nig = WGM * nN, gid = wgid / nig, fm = gid * WGM, gsz = (nM - fm) < WGM ? (nM - fm) : WGM;
        u.pm = fm + ((wgid % nig) % gsz); u.pn = (wgid % nig) / gsz; u.k0 = 0; u.nt = ntk; u.part = -1; return true;
    }
    __device__ __forceinline__ void a_ready(const Unit&) const {}
    __device__ __forceinline__ void done(const Unit&) const {}
};
struct TailOrder {
    StaticOrder so; int c, G;
    __host__ __device__ void init(int K, int G_, int c_) { so.init(9216, 42 * 256, K, G_, c_); c = c_; G = G_; }
    __host__ __device__ bool next(int i, Unit& u) const {
        if (i < 6) { const int L = i * G + c; if (L < 1512) return so.next(i, u); u.pm = L - 1512; u.pn = 42; u.k0 = 0; u.nt = so.ntk; u.part = -1; return true; }
#ifndef TAILSPLIT
#define TAILSPLIT 0
#endif
        if (!TAILSPLIT) { if (i != 6 || c >= 12) return false; u.pm = 24 + c; u.pn = 42; u.k0 = 0; u.nt = so.ntk; u.part = -1; return true; }
        if (i != 6 || c >= 96) return false;
        u.pm = 24 + (c >> 3); u.pn = 42; const int p = c & 7, S = so.ntk / 2; const int s0 = (p * S) / 8, s1 = ((p + 1) * S) / 8; u.k0 = 2 * s0; u.nt = 2 * (s1 - s0); u.part = p; return true;
    }
    __device__ __forceinline__ void a_ready(const Unit&) const {}
    __device__ __forceinline__ void done(const Unit&) const {}
};
struct SplitOrder {
    StaticOrder so; int c, S;
    __host__ __device__ void init(int K, int G_, int c_) { so.init(8192, 2048, K, G_, c_); c = c_; S = K / 128; }
    __host__ __device__ bool next(int i, Unit& u) const {
        if (i == 0) return so.next(0, u);
        if (i != 1) return false;
        const int t = c >> 3, p = c & 7; u.pm = 32 + (t >> 3); u.pn = t & 7; const int s0 = (p * S) / 8, s1 = ((p + 1) * S) / 8; u.k0 = 2 * s0; u.nt = 2 * (s1 - s0); u.part = p; return true;
    }
    __device__ __forceinline__ void a_ready(const Unit&) const {}
    __device__ __forceinline__ void done(const Unit&) const {}
};

__device__ __forceinline__ unsigned cvt_pk_bf16(float lo, float hi) { unsigned r; asm volatile("v_cvt_pk_bf16_f32 %0, %1, %2" : "=v"(r) : "v"(lo), "v"(hi)); return r; }

struct EpiBf16 {
    static constexpr bool PERM = true, AFTER_DRAIN = false, ROWPERM = false;
    bf16_t* O; int ldc;
    __device__ __forceinline__ void operator()(const f32x4 (&acc)[2][2][4][2], const Unit& u, int wr, int wc, int fr, int fq) const {
        const int row0 = u.pm * BM + wr * 64 + fr; const int col0 = u.pn * BM + wc * 32 + 8 * fq;
#pragma unroll
        for (int ai = 0; ai < 2; ++ai)
#pragma unroll
            for (int m = 0; m < 4; ++m) { bf16_t* rowp = O + (size_t)(row0 + ai * HALF + m * 16) * ldc + col0;
#pragma unroll
                for (int bj = 0; bj < 2; ++bj) { const f32x4 v0 = acc[ai][bj][m][0], v1 = acc[ai][bj][m][1];
                    u32x4 w; w.x = cvt_pk_bf16(v0[0], v0[1]); w.y = cvt_pk_bf16(v0[2], v0[3]); w.z = cvt_pk_bf16(v1[0], v1[1]); w.w = cvt_pk_bf16(v1[2], v1[3]);
                    *(u32x4*)(rowp + bj * HALF) = w; } }
    }
};
struct EpiResid {
    static constexpr bool PERM = false, AFTER_DRAIN = false, ROWPERM = false;
    const float* xp; const float* xs; float* X; const float* gate; float* slab;
    __device__ __forceinline__ void operator()(const f32x4 (&acc)[2][2][4][2], const Unit& u, int wr, int wc, int fr, int fq) const {
        const int row0 = u.pm * BM + wr * 64 + fr, col0 = u.pn * BM + wc * 32 + 4 * fq;
        if (u.part >= 0) {
            bf16_t* sb = (bf16_t*)slab + ((size_t)u.part * 1024 + (row0 - 8192)) * 2048 + col0;
#pragma unroll
            for (int ai = 0; ai < 2; ++ai)
#pragma unroll
                for (int m = 0; m < 4; ++m)
#pragma unroll
                    for (int bj = 0; bj < 2; ++bj)
#pragma unroll
                        for (int n = 0; n < 2; ++n) { const f32x4 v = acc[ai][bj][m][n]; typedef unsigned u32x2 __attribute__((ext_vector_type(2))); u32x2 w; w.x = cvt_pk_bf16(v[0], v[1]); w.y = cvt_pk_bf16(v[2], v[3]);
                            *(u32x2*)(sb + (size_t)(ai * HALF + m * 16) * 2048 + bj * HALF + n * 16) = w; }
            return; }
        const int bidx0 = (u.pm * BM < 8192) ? ((u.pm * BM) >> 11) : 4 + ((u.pm * BM - 8192) >> 3);
        const bool uni = u.pm * BM < 8192;
        f32x4 gvu[2][2];
#pragma unroll
        for (int bj = 0; bj < 2; ++bj)
#pragma unroll
            for (int n = 0; n < 2; ++n) gvu[bj][n] = *(const f32x4*)(gate + (size_t)bidx0 * 12288 + col0 + bj * HALF + n * 16);
#pragma unroll
        for (int h2 = 0; h2 < 4; ++h2) { f32x4 xv[2][2][2];
#pragma unroll
            for (int e = 0; e < 2; ++e) { const int jj = 2 * h2 + e, ai = jj >> 2, m = jj & 3; const int row = row0 + ai * HALF + m * 16;
                const float* xin = (row < 8192) ? xp + (size_t)row * 2048 : xs + (size_t)(row - 8192) * 2048;
#pragma unroll
                for (int bj = 0; bj < 2; ++bj)
#pragma unroll
                    for (int n = 0; n < 2; ++n) xv[e][bj][n] = *(const f32x4*)(xin + col0 + bj * HALF + n * 16); }
#pragma unroll
            for (int e = 0; e < 2; ++e) { const int jj = 2 * h2 + e, ai = jj >> 2, m = jj & 3; const int row = row0 + ai * HALF + m * 16;
                const int bidx = (row < 8192) ? (row >> 11) : 4 + ((row - 8192) >> 3);
                const float* gp = gate + (size_t)bidx * 12288; float* outp = X + (size_t)row * 2048;
#pragma unroll
                for (int bj = 0; bj < 2; ++bj)
#pragma unroll
                    for (int n = 0; n < 2; ++n) { const int c = col0 + bj * HALF + n * 16;
                        const f32x4 gv = uni ? gvu[bj][n] : *(const f32x4*)(gp + c);
                        *(f32x4*)(outp + c) = xv[e][bj][n] + gv * acc[ai][bj][m][n]; } }
            asm volatile("" ::: "memory"); }
    }
};


struct EpiAct {
    static constexpr bool PERM = true, AFTER_DRAIN = false, ROWPERM = true;
    static constexpr int FFN = 5504;
    bf16_t* ACT; const float* cw; const float* cbias; const float* st; float* sconv; float* HALO; float* FIXA; float* FIXB; float* slab;
    static __device__ __forceinline__ float silu1(float x) { return x * __builtin_amdgcn_rcpf(1.0f + __expf(-x)); }
    static __device__ __forceinline__ f32x4 silu4(f32x4 v) { return (f32x4){silu1(v.x), silu1(v.y), silu1(v.z), silu1(v.w)}; }
    static __device__ __forceinline__ float bp1(float v, int addr) { return __builtin_bit_cast(float, __builtin_amdgcn_ds_bpermute(addr, __builtin_bit_cast(int, v))); }
    static __device__ __forceinline__ f32x4 shl1(f32x4 v, int lane) { const int ad = (lane - 1) << 2; return (f32x4){bp1(v.x, ad), bp1(v.y, ad), bp1(v.z, ad), bp1(v.w, ad)}; }
    __device__ __forceinline__ void operator()(const f32x4 (&acc)[2][2][4][2], const Unit& u, int wr, int wc, int fr, int fq) const {
        const int tok0 = u.pm * BM + 128 * wr + 8 * fr;
        if (u.part >= 0) {
#pragma unroll
            for (int ai = 0; ai < 2; ++ai)
#pragma unroll
                for (int m = 0; m < 4; ++m) { float* q = slab + ((size_t)u.part * 3072 + (tok0 + 4 * ai + m - 6144)) * 256 + wc * 32 + 8 * fq;
#pragma unroll
                    for (int bj = 0; bj < 2; ++bj) { *(f32x4*)(q + bj * HALF) = acc[ai][bj][m][0]; *(f32x4*)(q + bj * HALF + 4) = acc[ai][bj][m][1]; } }
            return; }
        const bool sample = u.pm >= 32; const int lane = fq * 16 + fr; const int c8 = u.pn * 128 + wc * 32 + 8 * fq;
        const bool defer = !sample && fr == 0 && (tok0 & 2047) != 0; const int blk128 = tok0 >> 7; const int seq = (tok0 - 8192) >> 3;
        f32x4 w0[2], w1[2], w2[2], cb[2], am1[2], am2[2];
#pragma unroll
        for (int n = 0; n < 2; ++n) { const int c4 = c8 + 4 * n; w0[n] = *(const f32x4*)(cw + c4); w1[n] = *(const f32x4*)(cw + FFN + c4); w2[n] = *(const f32x4*)(cw + 2 * FFN + c4); cb[n] = *(const f32x4*)(cbias + c4);
            if (sample) { am2[n] = *(const f32x4*)(st + ((size_t)seq * 2 + 0) * FFN + c4); am1[n] = *(const f32x4*)(st + ((size_t)seq * 2 + 1) * FFN + c4);
                *(f32x4*)(sconv + ((size_t)seq * 2 + 0) * FFN + c4) = acc[1][0][2][n]; *(f32x4*)(sconv + ((size_t)seq * 2 + 1) * FFN + c4) = acc[1][0][3][n]; }
            else { am2[n] = shl1(acc[1][0][2][n], lane); am1[n] = shl1(acc[1][0][3][n], lane);
                if (fr == 0) { am1[n] = (f32x4){0.f, 0.f, 0.f, 0.f}; am2[n] = am1[n]; }
                if (fr == 15) { *(f32x4*)(HALO + ((size_t)blk128 * 2 + 0) * FFN + c4) = acc[1][0][2][n]; *(f32x4*)(HALO + ((size_t)blk128 * 2 + 1) * FFN + c4) = acc[1][0][3][n]; }
                if (defer) { *(f32x4*)(FIXA + ((size_t)blk128 * 2 + 0) * FFN + c4) = acc[0][0][0][n]; *(f32x4*)(FIXA + ((size_t)blk128 * 2 + 1) * FFN + c4) = acc[0][0][1][n];
                             *(f32x4*)(FIXB + ((size_t)blk128 * 2 + 0) * FFN + c4) = acc[0][1][0][n]; *(f32x4*)(FIXB + ((size_t)blk128 * 2 + 1) * FFN + c4) = acc[0][1][1][n]; } } }
#pragma unroll
        for (int jj = 0; jj < 8; ++jj) { const int ai = jj >> 2, m = jj & 3; u32x4 w;
#pragma unroll
            for (int n = 0; n < 2; ++n) { const f32x4 a0 = acc[ai][0][m][n];
                const f32x4 p1 = (jj == 0) ? am1[n] : acc[(jj - 1) >> 2][0][(jj - 1) & 3][n];
                const f32x4 p2 = (jj == 0) ? am2[n] : (jj == 1) ? am1[n] : acc[(jj - 2) >> 2][0][(jj - 2) & 3][n];
                const f32x4 o = silu4(cb[n] + w0[n] * p2 + w1[n] * p1 + w2[n] * a0) * acc[ai][1][m][n];
                if (n == 0) { w.x = cvt_pk_bf16(o[0], o[1]); w.y = cvt_pk_bf16(o[2], o[3]); } else { w.z = cvt_pk_bf16(o[0], o[1]); w.w = cvt_pk_bf16(o[2], o[3]); } }
            if (!(defer && jj < 2)) *(u32x4*)(ACT + (size_t)(tok0 + jj) * FFN + c8) = w; }
    }
};

struct EpiBf16R {
    static constexpr bool PERM = true, AFTER_DRAIN = false, ROWPERM = true;
    bf16_t* O; int ldc;
    __device__ __forceinline__ void operator()(const f32x4 (&acc)[2][2][4][2], const Unit& u, int wr, int wc, int fr, int fq) const {
        const int tok0 = u.pm * BM + 128 * wr + 8 * fr; const int col0 = u.pn * BM + wc * 32 + 8 * fq;
#pragma unroll
        for (int ai = 0; ai < 2; ++ai)
#pragma unroll
            for (int m = 0; m < 4; ++m) { bf16_t* rowp = O + (size_t)(tok0 + 4 * ai + m) * ldc + col0;
#pragma unroll
                for (int bj = 0; bj < 2; ++bj) { const f32x4 v0 = acc[ai][bj][m][0], v1 = acc[ai][bj][m][1];
                    u32x4 w; w.x = cvt_pk_bf16(v0[0], v0[1]); w.y = cvt_pk_bf16(v0[2], v0[3]); w.z = cvt_pk_bf16(v1[0], v1[1]); w.w = cvt_pk_bf16(v1[2], v1[3]);
                    *(u32x4*)(rowp + bj * HALF) = w; } }
    }
};

template <class Epi, class Sched, bool ALIGN_EPI = false, bool SP2 = false>
__device__ __forceinline__ void gemm_phase(PG8_LAS unsigned char* lds, const Gemm g, const Sched& S, const Epi& E, const int tid) {
    const int wid = __builtin_amdgcn_readfirstlane(tid >> 6), lane = tid & 63, wr = wid >> 2, wc = wid & 3, fr = lane & 15, fq = lane >> 4;
    const int K = g.K;
    unsigned voffA[2], voffB[2];
#pragma unroll
    for (int i = 0; i < 2; ++i) { int R, C; stage_rc(tid * 16 + i * 8192, R, C); const int Rb = Epi::PERM ? ((R & ~31) + perm32(R & 31)) : R;
        const int Ra = Epi::ROWPERM ? (128 * (R >> 6) + 8 * (R & 15) + ((R >> 4) & 3)) : R;
        voffA[i] = (unsigned)(Ra * K + C) * 2u; voffB[i] = (unsigned)(Rb * K + C) * 2u; }
    const size_t kstep = (size_t)(BK * 2);
    const size_t hstep = (size_t)HALF * K * 2;
    const size_t hstepA = Epi::ROWPERM ? (size_t)4 * K * 2 : hstep;
    const size_t tstep = 2 * hstep;
    const unsigned ldsw = (unsigned)wid * 1024u;
    const int aoff = lds_byte(wr * 64 + fr, fq * 8), boff = lds_byte(wc * 32 + fr, fq * 8);
#define PG8_SA(b, h) (((b) * 2 + (h)) * HTB)
#define PG8_SB(b, h) ((4 + (b) * 2 + (h)) * HTB)
#define PG8_STAGE(bufoff, gbase, voff) do { _Pragma("unroll") for (int _i = 0; _i < 2; ++_i) \
        __builtin_amdgcn_global_load_lds((const unsigned*)((const char*)(gbase) + (voff)[_i]), (PG8_LAS unsigned*)(lds + (bufoff) + ldsw + _i * 8192), 16, 0, 0); } while (0)
#define PG8_LDA(dst, b, h) do { _Pragma("unroll") for (int m = 0; m < 4; ++m) _Pragma("unroll") for (int k = 0; k < 2; ++k) dst[m][k] = *(const PG8_LAS bf16x8*)(lds + PG8_SA(b, h) + aoff + m * 2048 + k * 1024); } while (0)
#define PG8_LDB(dst, b, h) do { _Pragma("unroll") for (int n = 0; n < 2; ++n) _Pragma("unroll") for (int k = 0; k < 2; ++k) dst[n][k] = *(const PG8_LAS bf16x8*)(lds + PG8_SB(b, h) + boff + n * 2048 + k * 1024); } while (0)
#define PG8_MMA(ai, bj, At, Bt) do { __builtin_amdgcn_s_setprio(1); _Pragma("unroll") for (int m = 0; m < 4; ++m) _Pragma("unroll") for (int n = 0; n < 2; ++n) _Pragma("unroll") for (int k = 0; k < 2; ++k) \
        acc[ai][bj][m][n] = __builtin_amdgcn_mfma_f32_16x16x32_bf16(Bt[n][k], At[m][k], acc[ai][bj][m][n], 0, 0, 0); __builtin_amdgcn_s_setprio(0); } while (0)
#define PG8_WAIT_V(n) asm volatile("s_waitcnt vmcnt(" #n ")" ::: "memory")
#define PG8_WAIT_L(n) asm volatile("s_waitcnt lgkmcnt(" #n ")" ::: "memory")
#define PG8_BAR __builtin_amdgcn_s_barrier()
#define PG8_SCHED __builtin_amdgcn_sched_barrier(0)
    Unit cur, nxt; int ui = 0;
    if (!S.next(0, cur)) return;
    f32x4 acc[2][2][4][2];
#pragma unroll
    for (int a = 0; a < 2; ++a)
#pragma unroll
        for (int b = 0; b < 2; ++b)
#pragma unroll
            for (int m = 0; m < 4; ++m)
#pragma unroll
                for (int n = 0; n < 2; ++n) acc[a][b][m][n] = (f32x4){0.f, 0.f, 0.f, 0.f};
    bf16x8 At[4][2], B0[2][2], B1[2][2];
    const char* cA = (const char*)g.A + (size_t)cur.pm * tstep + (size_t)cur.k0 * kstep; const char* cB = (const char*)g.Bt + (size_t)cur.pn * tstep + (size_t)cur.k0 * kstep;
    S.a_ready(cur);
    if constexpr (SP2) {
        PG8_STAGE(PG8_SB(0, 0), cB, voffB); PG8_STAGE(PG8_SB(0, 1), cB + hstep, voffB); PG8_STAGE(PG8_SA(0, 0), cA, voffA); PG8_STAGE(PG8_SA(0, 1), cA + hstepA, voffA);
        if (wr == 1) PG8_BAR;
        PG8_WAIT_V(2); PG8_BAR;
        PG8_STAGE(PG8_SB(1, 0), cB + kstep, voffB); PG8_STAGE(PG8_SA(1, 0), cA + kstep, voffA); PG8_STAGE(PG8_SB(1, 1), cB + hstep + kstep, voffB);
        PG8_WAIT_V(6); PG8_BAR;
    } else {
        PG8_STAGE(PG8_SB(0, 0), cB, voffB); PG8_STAGE(PG8_SA(0, 0), cA, voffA); PG8_STAGE(PG8_SB(0, 1), cB + hstep, voffB); PG8_STAGE(PG8_SA(0, 1), cA + hstepA, voffA);
        if (wr == 1) PG8_BAR;
        PG8_WAIT_V(4); PG8_BAR;
        PG8_STAGE(PG8_SB(1, 0), cB + kstep, voffB); PG8_STAGE(PG8_SA(1, 0), cA + kstep, voffA); PG8_STAGE(PG8_SB(1, 1), cB + hstep + kstep, voffB);
        PG8_WAIT_V(6); PG8_BAR;
    }
    for (;;) {
        const bool has_next = S.next(ui + 1, nxt);
        const char* nA = has_next ? (const char*)g.A + (size_t)nxt.pm * tstep + (size_t)nxt.k0 * kstep : cA; const char* nB = has_next ? (const char*)g.Bt + (size_t)nxt.pn * tstep + (size_t)nxt.k0 * kstep : cB;
        const int nt = cur.nt;
        for (int t = 0; t < nt; t += 2) {
            const bool last = (t == nt - 2);
            const char* a1 = cA + (size_t)(t + 1) * kstep;
            const char* a2 = last ? nA : cA + (size_t)(t + 2) * kstep; const char* b2 = last ? nB : cB + (size_t)(t + 2) * kstep;
            const char* a3 = a2 + kstep; const char* b3 = b2 + kstep;
            if (last && has_next) S.a_ready(nxt);
            if constexpr (SP2) {
            PG8_LDB(B0, 0, 0); PG8_LDB(B1, 0, 1); PG8_SCHED; PG8_LDA(At, 0, 0); PG8_STAGE(PG8_SA(1, 1), a1 + hstepA, voffA);
            PG8_WAIT_V(8); PG8_WAIT_L(0); PG8_BAR; PG8_MMA(0, 0, At, B0); PG8_MMA(0, 1, At, B1); PG8_BAR; PG8_SCHED;
            PG8_LDA(At, 0, 1); PG8_STAGE(PG8_SB(0, 0), b2, voffB); PG8_STAGE(PG8_SB(0, 1), b2 + hstep, voffB); PG8_STAGE(PG8_SA(0, 0), a2, voffA);
            PG8_WAIT_V(8); PG8_WAIT_L(0); PG8_BAR; PG8_MMA(1, 0, At, B0); PG8_MMA(1, 1, At, B1); PG8_BAR; PG8_SCHED;
            PG8_LDB(B0, 1, 0); PG8_LDB(B1, 1, 1); PG8_SCHED; PG8_LDA(At, 1, 0); PG8_STAGE(PG8_SA(0, 1), a2 + hstepA, voffA);
            PG8_WAIT_V(8); PG8_WAIT_L(0); PG8_BAR; PG8_MMA(0, 0, At, B0); PG8_MMA(0, 1, At, B1); PG8_BAR; PG8_SCHED;
            PG8_LDA(At, 1, 1); PG8_STAGE(PG8_SB(1, 0), b3, voffB); PG8_STAGE(PG8_SB(1, 1), b3 + hstep, voffB); PG8_STAGE(PG8_SA(1, 0), a3, voffA);
            PG8_WAIT_V(8); PG8_WAIT_L(0); PG8_BAR; PG8_MMA(1, 0, At, B0); PG8_MMA(1, 1, At, B1); PG8_BAR; PG8_SCHED;
            } else {
            PG8_LDB(B0, 0, 0); PG8_SCHED; PG8_LDA(At, 0, 0); PG8_STAGE(PG8_SA(1, 1), a1 + hstepA, voffA);
            PG8_WAIT_L(8); PG8_BAR; PG8_WAIT_L(0); PG8_MMA(0, 0, At, B0); PG8_BAR; PG8_SCHED;
            PG8_LDB(B1, 0, 1); PG8_STAGE(PG8_SB(0, 0), b2, voffB);
            PG8_BAR; PG8_WAIT_L(0); PG8_MMA(0, 1, At, B1); PG8_BAR;
            PG8_LDA(At, 0, 1); PG8_STAGE(PG8_SA(0, 0), a2, voffA);
            PG8_BAR; PG8_WAIT_L(0); PG8_MMA(1, 0, At, B0); PG8_BAR; PG8_SCHED;
            PG8_STAGE(PG8_SB(0, 1), b2 + hstep, voffB);
            PG8_WAIT_V(6); PG8_BAR; PG8_MMA(1, 1, At, B1); PG8_BAR;
            PG8_LDB(B0, 1, 0); PG8_SCHED; PG8_LDA(At, 1, 0); PG8_STAGE(PG8_SA(0, 1), a2 + hstepA, voffA);
            PG8_WAIT_L(8); PG8_BAR; PG8_WAIT_L(0); PG8_MMA(0, 0, At, B0); PG8_BAR; PG8_SCHED;
            PG8_LDB(B1, 1, 1); PG8_STAGE(PG8_SB(1, 0), b3, voffB);
            PG8_BAR; PG8_WAIT_L(0); PG8_MMA(0, 1, At, B1); PG8_BAR;
            PG8_LDA(At, 1, 1); PG8_STAGE(PG8_SA(1, 0), a3, voffA);
            PG8_BAR; PG8_WAIT_L(0); PG8_MMA(1, 0, At, B0); PG8_BAR; PG8_SCHED;
            PG8_STAGE(PG8_SB(1, 1), b3 + hstep, voffB);
            PG8_WAIT_V(6); PG8_BAR; PG8_MMA(1, 1, At, B1); PG8_BAR;
            }
        }
        if constexpr (ALIGN_EPI) { if (wr == 0) PG8_BAR; }
        if constexpr (!Epi::AFTER_DRAIN) { int ln_; asm volatile("v_mbcnt_lo_u32_b32 %0, -1, 0\n\tv_mbcnt_hi_u32_b32 %0, -1, %0" : "=v"(ln_));
            E(acc, cur, wr, wc, ln_ & 15, ln_ >> 4); S.done(cur); }
        if (!has_next) break;
#pragma unroll
        for (int a = 0; a < 2; ++a)
#pragma unroll
            for (int b = 0; b < 2; ++b)
#pragma unroll
                for (int m = 0; m < 4; ++m)
#pragma unroll
                    for (int n = 0; n < 2; ++n) acc[a][b][m][n] = (f32x4){0.f, 0.f, 0.f, 0.f};
        cur = nxt; cA = nA; cB = nB; ++ui;
        if constexpr (ALIGN_EPI) { if (wr == 1) PG8_BAR; }
    }
    PG8_WAIT_V(0);
    if constexpr (!ALIGN_EPI) { if (wr == 0) PG8_BAR; }
    PG8_BAR;
#undef PG8_SA
#undef PG8_SB
#undef PG8_STAGE
#undef PG8_LDA
#undef PG8_LDB
#undef PG8_MMA
#undef PG8_WAIT_V
#undef PG8_WAIT_L
#undef PG8_BAR
#undef PG8_SCHED
}
}

constexpr int NWAVES = 8, NTHR = 512;
constexpr int DM = 2048, PB = 4, PSEQ = 2048, DEPTH = 2, SB = 128, SSEQ = 8, PAST = 16384;
constexpr int MP = PB * PSEQ, MS = SB * SSEQ, MT = MP + MS;
constexpr int NCOND = PB + SB;
constexpr int D_SSM = 512, D_RET = 1024, D_POOL = 512, NG = 32, NST = 64, NH = 8, HD = 128, FF = 5504, DIN = 5120, NMOD = 6 * DM;
constexpr int C_UA = 0, C_Q = 512, C_K = 1536, C_V = 2560, C_G = 3584, C_UC = 4608;
constexpr int NCHUNK = PSEQ / 128;
constexpr int NBLK = PSEQ / 32;
constexpr float EPS = 1e-6f;

constexpr size_t al256(size_t x) { return (x + 255) & ~(size_t)255; }
constexpr size_t WS_CTL = 0, CTL_ZERO_BYTES = 1u << 20;
constexpr size_t WS_ROPEP = CTL_ZERO_BYTES;
constexpr size_t WS_ROPES = WS_ROPEP + (size_t)PSEQ * 64 * 8;
constexpr size_t WS_SAB = WS_ROPES + al256(8 * 64 * 8);
constexpr size_t WS_SA32 = WS_SAB + (size_t)DEPTH * NG * NST * 8;
constexpr size_t WS_SBB = WS_SA32 + (size_t)DEPTH * NG * NST * 8;
constexpr size_t WS_SCM = WS_SBB + (size_t)DEPTH * NG * 128 * 16 * 2;
constexpr size_t WS_SC = WS_SCM + (size_t)DEPTH * NG * 16 * 128 * 2;
constexpr size_t WS_MOD = WS_SC + (size_t)144 * DM * 2;
constexpr size_t WS_E = al256(WS_MOD + (size_t)DEPTH * NCOND * NMOD * 4);
constexpr size_t WS_HIN = WS_E + (size_t)PB * NBLK * NG * NST * 8;
constexpr size_t WS_W = al256(WS_HIN + (size_t)PB * NBLK * NG * NST * 8);
constexpr size_t W_IN = 0, W_OUT = W_IN + (size_t)DIN * DM * 2, W_UP = W_OUT + (size_t)DM * DM * 2, W_DOWN = W_UP + (size_t)2 * FF * DM * 2,
                 W_GLU = W_DOWN + (size_t)DM * FF * 2, W_POOL = W_GLU + (size_t)D_SSM * D_SSM * 2, W_LAYER = W_POOL + (size_t)4 * 128 * 128 * 2;
constexpr size_t WS_X = al256(WS_W + DEPTH * W_LAYER);
constexpr size_t WS_H = WS_X + (size_t)MT * DM * 4;
constexpr size_t WS_R1 = WS_H + (size_t)MT * DM * 2;
constexpr size_t R1_PROJ = 0, R1_MIX = R1_PROJ + (size_t)MT * DIN * 2, R1_KV = R1_MIX + (size_t)MT * DM * 2,
                 R1_SPT = R1_KV + (size_t)PB * NH * NCHUNK * 128 * 128 * 4, R1_END = R1_SPT + (size_t)PB * NH * NCHUNK * 128 * 128 * 2;
constexpr size_t R1_AB_BYTES = (size_t)MT * 2 * FF * 2;
constexpr size_t R1_BYTES = R1_END > R1_AB_BYTES ? R1_END : R1_AB_BYTES;
constexpr size_t WS_ACT = al256(WS_R1 + R1_BYTES);
constexpr size_t WS_END = WS_ACT + (size_t)MT * FF * 2;

constexpr size_t O_YP = 0, O_YS = O_YP + (size_t)MP * DM, O_PRE = O_YS + (size_t)MS * DM, O_PIM = O_PRE + (size_t)DEPTH * PB * NG * NST,
                 O_PRET = O_PIM + (size_t)DEPTH * PB * NG * NST, O_PPOOL = O_PRET + (size_t)DEPTH * PB * NH * HD * HD, O_PCONV = O_PPOOL + (size_t)DEPTH * PB * 15 * D_POOL,
                 O_SRE = O_PCONV + (size_t)DEPTH * PB * 2 * FF, O_SIM = O_SRE + (size_t)DEPTH * SB * NG * NST, O_SRET = O_SIM + (size_t)DEPTH * SB * NG * NST,
                 O_SPOOL = O_SRET + (size_t)DEPTH * SB * NH * HD * HD, O_SCONV = O_SPOOL + (size_t)DEPTH * SB * 15 * D_POOL, O_END = O_SCONV + (size_t)DEPTH * SB * 2 * FF;

constexpr int CW_BAR = 4096;
constexpr int RING_BYTES = 131072;
constexpr int LDSCTL_OFF = RING_BYTES, MISC_OFF = LDSCTL_OFF + 320;
constexpr int LDS_BYTES = 147456;

#define GAS __attribute__((address_space(1)))
#define LAS __attribute__((address_space(3)))
typedef unsigned short bf16;
typedef unsigned v4u __attribute__((ext_vector_type(4)));
typedef unsigned v2u __attribute__((ext_vector_type(2)));
typedef float f32x4 __attribute__((ext_vector_type(4)));
typedef float f32x2 __attribute__((ext_vector_type(2)));
typedef short bf16x8 __attribute__((ext_vector_type(8)));
#define RLX_AGENT __ATOMIC_RELAXED, __HIP_MEMORY_SCOPE_AGENT
#define LDS_WAIT() asm volatile("s_waitcnt lgkmcnt(0)" ::: "memory")
#define VM_WAIT() asm volatile("s_waitcnt vmcnt(0)" ::: "memory")
#define CFENCE() asm volatile("" ::: "memory")
__device__ __forceinline__ unsigned pk2(float lo, float hi) { unsigned r; asm("v_cvt_pk_bf16_f32 %0, %1, %2" : "=v"(r) : "v"(lo), "v"(hi)); return r; }
__device__ __forceinline__ unsigned f2bf(float f) { return pk2(f, f) & 0xffffu; }
__device__ __forceinline__ float bf2f(unsigned b) { return __builtin_bit_cast(float, b << 16); }
__device__ __forceinline__ float bflo(unsigned w) { return __builtin_bit_cast(float, w << 16); }
__device__ __forceinline__ float bfhi(unsigned w) { return __builtin_bit_cast(float, w & 0xffff0000u); }
__device__ __forceinline__ float fsigmoid(float x) { return __builtin_amdgcn_rcpf(1.0f + __expf(-x)); }
__device__ __forceinline__ float fsilu(float x) { return x * __builtin_amdgcn_rcpf(1.0f + __expf(-x)); }
__device__ __forceinline__ float gelu_tanh(float x) { const float u = 0.7978845608028654f * (x + 0.044715f * x * x * x); const float e = __expf(2.0f * u); const float th = 1.0f - 2.0f * __builtin_amdgcn_rcpf(e + 1.0f); return 0.5f * x * (1.0f + th); }
__device__ __forceinline__ float xshfl(float v, int o, int lane) { return __builtin_bit_cast(float, __builtin_amdgcn_ds_bpermute((lane ^ o) << 2, __builtin_bit_cast(int, v))); }
__device__ __forceinline__ float wave_sum(float v, int lane) {
#pragma unroll
    for (int o = 1; o < 64; o <<= 1) v += xshfl(v, o, lane);
    return v;
}
__device__ __forceinline__ float sum16(float v, int lane) {
#pragma unroll
    for (int o = 1; o < 16; o <<= 1) v += xshfl(v, o, lane);
    return v;
}
__device__ __forceinline__ void sincos_acc(float xf, float& c, float& s) {
    const double x = (double)xf;
    const double n = __builtin_rint(x * 0.63661977236758134308);
    double r = __builtin_fma(-n, 1.57079632673412561417e+00, x);
    r = __builtin_fma(-n, 6.07710050650619224932e-11, r);
    const double z = r * r;
    const double sp = r + r * z * (-1.66666666666666324348e-01 + z * (8.33333333332248946124e-03 + z * (-1.98412698298579493134e-04 + z * (2.75573137070700676789e-06 + z * (-2.50507602534068634195e-08 + z * 1.58969099521155010221e-10)))));
    const double cp = 1.0 - 0.5 * z + z * z * (4.16666666666666019037e-02 + z * (-1.38888888888741095749e-03 + z * (2.48015872894767294178e-05 + z * (-2.75573143513906633035e-07 + z * (2.08757232129817482790e-09 + z * -1.13596475577881948265e-11)))));
    const int q = ((int)n) & 3;
    const double sv = (q == 0) ? sp : (q == 1) ? cp : (q == 2) ? -sp : -cp;
    const double cv = (q == 0) ? cp : (q == 1) ? -sp : (q == 2) ? -cp : sp;
    s = (float)sv; c = (float)cv;
}
__device__ __forceinline__ float ret_lg(int h) {
    const float x = __builtin_bit_cast(float, (unsigned)((127 - 5 - h) << 23));
    return -x * (1.0f + x * (0.5f + x * (0.33333334f + x * (0.25f + x * (0.2f + x * (0.16666667f + x * 0.14285715f))))));
}

__device__ const float rope_inv[64] = {
1.000000000e+00f, 8.659643531e-01f, 7.498942614e-01f, 6.493816376e-01f, 5.623413324e-01f, 4.869675338e-01f, 4.216965139e-01f, 3.651741147e-01f, 3.162277639e-01f, 2.738419771e-01f, 2.371373773e-01f, 2.053525001e-01f, 1.778279394e-01f, 1.539926529e-01f, 1.333521307e-01f, 1.154782027e-01f, 1.000000015e-01f, 8.659642935e-02f, 7.498941571e-02f, 6.493816525e-02f, 5.623413250e-02f, 4.869675264e-02f, 4.216965288e-02f, 3.651741147e-02f, 3.162277490e-02f, 2.738419734e-02f, 2.371373773e-02f, 2.053525113e-02f, 1.778279431e-02f, 1.539926510e-02f, 1.333521493e-02f, 1.154782064e-02f, 9.999999776e-03f, 8.659643121e-03f, 7.498941850e-03f, 6.493816152e-03f, 5.623413250e-03f, 4.869675264e-03f, 4.216964822e-03f, 3.651741194e-03f, 3.162277630e-03f, 2.738419687e-03f, 2.371373586e-03f, 2.053524833e-03f, 1.778279431e-03f, 1.539926510e-03f, 1.333521446e-03f, 1.154781901e-03f, 1.000000047e-03f, 8.659643354e-04f, 7.498942432e-04f, 6.493816618e-04f, 5.623413017e-04f, 4.869675322e-04f, 4.216965172e-04f, 3.651741426e-04f, 3.162277571e-04f, 2.738419571e-04f, 2.371373703e-04f, 2.053525095e-04f, 1.778279402e-04f, 1.539926452e-04f, 1.333521504e-04f, 1.154782003e-04f };

#define XB_TMO      128
#define XB_XCNT(j)  (256  + 64 * (j))
#define XB_XSUB(j)  (1280 + 64 * (j))
#define XB_XGEN(j)  (2304 + 64 * (j))
#define XB_TOP      3328
#define XB_TOPGEN   3392
#define XCD_BAR_WORDS 3456
#define XB_SPIN_CAP (1u << 18)
__device__ __forceinline__ unsigned xb_ld(unsigned* p)              { return __hip_atomic_load(p, __ATOMIC_RELAXED, __HIP_MEMORY_SCOPE_AGENT); }
__device__ __forceinline__ unsigned xb_add(unsigned* p, unsigned v) { return __hip_atomic_fetch_add(p, v, __ATOMIC_RELAXED, __HIP_MEMORY_SCOPE_AGENT); }
__device__ __forceinline__ unsigned xb_xcc_id() { return (unsigned)__builtin_amdgcn_s_getreg((3 << 11) | 20) & 0xFu; }
#define XB_SPIN(cond, bar) do { unsigned _sp = 0; while (cond) { __builtin_amdgcn_s_sleep(1); \
    if ((++_sp & 255u) == 0u) { if (xb_ld(&(bar)[XB_TMO])) break; if (_sp > XB_SPIN_CAP) { atomicAdd(&(bar)[XB_TMO], 1u); break; } } } } while (0)
struct XcdBarrier { unsigned* bar; unsigned x; volatile LAS unsigned* st; };
__device__ __forceinline__ XcdBarrier xcd_barrier_post(unsigned* bar, volatile LAS unsigned* st) {
    XcdBarrier b; b.bar = bar; b.x = xb_xcc_id(); b.st = st;
    if (threadIdx.x == 0) (void)xb_add(&bar[XB_XCNT(b.x)], 1u);
    return b;
}
__device__ __forceinline__ void xcd_barrier_complete(unsigned* bar, unsigned x, unsigned& nloc, unsigned& nx) {
    const unsigned G = gridDim.x * gridDim.y * gridDim.z;
    unsigned sum, cnt, mine, sp = 0u;
    for (;;) {
        sum = 0u; cnt = 0u; mine = 0u;
#pragma unroll
        for (unsigned j = 0; j < 16; ++j) { const unsigned c = xb_ld(&bar[XB_XCNT(j)]); sum += c; cnt += (c > 0u) ? 1u : 0u; mine = (j == x) ? c : mine; }
        if (sum == G) break;
        __builtin_amdgcn_s_sleep(1);
        if ((++sp & 255u) == 0u) { if (xb_ld(&bar[XB_TMO])) break; if (sp > XB_SPIN_CAP) { atomicAdd(&bar[XB_TMO], 1u); break; } }
    }
    nloc = mine > 0u ? mine : 1u; nx = cnt > 0u ? cnt : 1u;
}
__device__ __forceinline__ void xcd_barrier(const XcdBarrier& b, const bool leader  ) {
    asm volatile("s_waitcnt vmcnt(0)" ::: "memory");
    __syncthreads();
    if (leader) {
        unsigned* bar = b.bar;
        __builtin_amdgcn_s_waitcnt(0);
        unsigned nloc = b.st[0], nx = b.st[1];
        if (nloc == 0u) { xcd_barrier_complete(bar, b.x, nloc, nx); b.st[0] = nloc; b.st[1] = nx; }
        const unsigned old = xb_add(&bar[XB_XSUB(b.x)], 1u);
        const unsigned gen = old / nloc;
        if (old + 1u == (gen + 1u) * nloc) {
            __builtin_amdgcn_fence(__ATOMIC_RELEASE, "agent");
            asm volatile("s_waitcnt vmcnt(0)" ::: "memory");
            const unsigned og = xb_add(&bar[XB_TOP], 1u);
            const unsigned tg = og / nx;
            if (og + 1u == (tg + 1u) * nx) xb_add(&bar[XB_TOPGEN], 1u);
            else XB_SPIN(xb_ld(&bar[XB_TOPGEN]) == tg, bar);
            __builtin_amdgcn_fence(__ATOMIC_ACQUIRE, "agent");
            xb_add(&bar[XB_XGEN(b.x)], 1u);
            asm volatile("s_waitcnt vmcnt(0)" ::: "memory");
        } else {
            XB_SPIN(xb_ld(&bar[XB_XGEN(b.x)]) == gen, bar);
            __builtin_amdgcn_fence(__ATOMIC_ACQUIRE, "agent");
            asm volatile("s_waitcnt vmcnt(0)" ::: "memory");
        }
    }
    __syncthreads();
}

struct Args { const float* in[32]; float* out; unsigned char* ws; int ph_lo, ph_hi; };

typedef float f32x3a __attribute__((ext_vector_type(3), aligned(4)));
#define MFMA16(a, b, c) __builtin_amdgcn_mfma_f32_16x16x32_bf16((a), (b), (c), 0, 0, 0)
#define SETTLE1(a) asm volatile("s_nop 15" : "+v"(a))
#define SETTLE4(a, b, c, d) asm volatile("s_nop 15" : "+v"(a), "+v"(b), "+v"(c), "+v"(d))
#define SETTLE8(x) asm volatile("s_nop 15" : "+v"((x)[0]), "+v"((x)[1]), "+v"((x)[2]), "+v"((x)[3]), "+v"((x)[4]), "+v"((x)[5]), "+v"((x)[6]), "+v"((x)[7]))

__device__ __forceinline__ void tr_item(const float* W, int N, int k0, int n0, bf16* WT, int K, int drow0, LAS float* scr, int lane) {
    float tmp[32];
    const float* wp = W + (size_t)(k0 + (lane >> 5)) * N + n0 + (lane & 31);
#pragma unroll
    for (int i = 0; i < 32; ++i) tmp[i] = __builtin_nontemporal_load(wp + (size_t)(2 * i) * N);
#pragma unroll
    for (int i = 0; i < 32; ++i) scr[(2 * i + (lane >> 5)) * 33 + (lane & 31)] = tmp[i];
    LDS_WAIT(); CFENCE();
    const int c = lane & 7;
#pragma unroll
    for (int j = 0; j < 4; ++j) { const int n = (lane >> 3) + 8 * j; const LAS float* s = scr + (8 * c) * 33 + n;
        v4u o; o.x = pk2(s[0 * 33], s[1 * 33]); o.y = pk2(s[2 * 33], s[3 * 33]); o.z = pk2(s[4 * 33], s[5 * 33]); o.w = pk2(s[6 * 33], s[7 * 33]);
        *(GAS v4u*)(WT + (size_t)(drow0 + n) * K + k0 + 8 * c) = o; }
    LDS_WAIT(); CFENCE();
}

constexpr int I_IN = (DM / 64) * (DIN / 32), I_OUT = (DM / 64) * (DM / 32), I_UP = (DM / 64) * (2 * FF / 32), I_DOWN = (FF / 64) * (DM / 32), I_GLU = (D_SSM / 64) * (D_SSM / 32), I_POOL = 4 * 2 * 4;
constexpr int I_LAYER = I_IN + I_OUT + I_UP + I_DOWN + I_GLU + I_POOL, I_PRE = I_IN + I_OUT + I_UP;
constexpr int I_UP3 = 3584, I_UP4 = 5000, I_UPH = I_UP / 2;
__device__ __forceinline__ bool tr_deferred(int l, int r) { return l == 0 ? ((r >= I_IN && r < I_IN + I_OUT + I_UP3 + I_UP4) || (r >= I_PRE && r < I_PRE + I_DOWN)) : (r < I_PRE + I_DOWN); }
__device__ __forceinline__ void tr_dispatch(const Args& a, unsigned char* ws, int l, int r, LAS float* scr, int lane) {
    bf16* wl = (bf16*)(ws + WS_W + (size_t)l * W_LAYER);
    if (r < I_IN) { const int nb = DIN / 32; tr_item(a.in[12] + (size_t)l * DM * DIN, DIN, 64 * (r / nb), 32 * (r % nb), (bf16*)((char*)wl + W_IN), DM, 32 * (r % nb), scr, lane); return; } r -= I_IN;
    if (r < I_OUT) { const int nb = DM / 32; tr_item(a.in[25] + (size_t)l * DM * DM, DM, 64 * (r / nb), 32 * (r % nb), (bf16*)((char*)wl + W_OUT), DM, 32 * (r % nb), scr, lane); return; } r -= I_OUT;
    if (r < I_UP) { const int nb = 2 * FF / 32; const int n0 = 32 * (r % nb); const int part = n0 / FF, c = n0 % FF; const int drow = 256 * (c / 128) + 128 * part + (c % 128);
        tr_item(a.in[27] + (size_t)l * DM * 2 * FF, 2 * FF, 64 * (r / nb), n0, (bf16*)((char*)wl + W_UP), DM, drow, scr, lane); return; } r -= I_UP;
    if (r < I_DOWN) { const int nb = DM / 32; tr_item(a.in[30] + (size_t)l * FF * DM, DM, 64 * (r / nb), 32 * (r % nb), (bf16*)((char*)wl + W_DOWN), FF, 32 * (r % nb), scr, lane); return; } r -= I_DOWN;
    if (r < I_GLU) { const int nb = D_SSM / 32; tr_item(a.in[21] + (size_t)l * D_SSM * D_SSM, D_SSM, 64 * (r / nb), 32 * (r % nb), (bf16*)((char*)wl + W_GLU), D_SSM, 32 * (r % nb), scr, lane); return; } r -= I_GLU;
    { const int gi = r / 8, q = r % 8; tr_item(a.in[23] + ((size_t)l * 4 + gi) * 128 * 128, 128, 64 * (q / 4), 32 * (q % 4), (bf16*)((char*)wl + W_POOL) + (size_t)gi * 128 * 128, 128, 32 * (q % 4), scr, lane); }
}
__device__ __forceinline__ void fill_range(const Args& a, unsigned char* ws, LAS unsigned char* lds, int l, int r0, int n, int fw, int nfw, int lane, int wave) {
    LAS float* scr = (LAS float*)(lds + wave * 16384);
    for (int it = fw; it < n; it += nfw) tr_dispatch(a, ws, l, r0 + it, scr, lane);
}
__device__ __forceinline__ void phase_p0a(const Args& a, unsigned char* ws, LAS unsigned char* lds, int vcu, int G, int tid, int wave, int lane) {
    const int gt = vcu * NTHR + tid, NT = G * NTHR;
    { f32x2* rp = (f32x2*)(ws + WS_ROPEP);
      for (int i = gt; i < PSEQ * 64; i += NT) { const int t = i >> 6, d = i & 63; float c, s; sincos_acc((float)t * rope_inv[d], c, s); rp[i] = (f32x2){c, s}; }
      f32x2* rs = (f32x2*)(ws + WS_ROPES);
      for (int i = gt; i < SSEQ * 64; i += NT) { const int t = i >> 6, d = i & 63; float c, s; sincos_acc((float)(PAST + t) * rope_inv[d], c, s); rs[i] = (f32x2){c, s}; } }
    { bf16* sc = (bf16*)(ws + WS_SC); const float* cp = a.in[7]; const float* cs = a.in[8];
      for (int i = gt; i < 144 * DM; i += NT) { const int r = i / DM, k = i % DM; float v = 0.f; if (r < PB) v = cp[r * DM + k]; else if (r < NCOND) v = cs[(r - PB) * DM + k]; sc[i] = (bf16)f2bf(r < NCOND ? fsilu(v) : 0.f); } }
    { const float* a_re = a.in[13]; const float* a_im = a.in[14]; const float* log_dt = a.in[15]; const float* b_re = a.in[16]; const float* b_im = a.in[17]; const float* c_re = a.in[18]; const float* c_im = a.in[19];
      f32x2* AB = (f32x2*)(ws + WS_SAB); f32x2* A32 = (f32x2*)(ws + WS_SA32); bf16* BB = (bf16*)(ws + WS_SBB); bf16* CM = (bf16*)(ws + WS_SCM);
      for (int u = gt; u < DEPTH * NG * NST * 16; u += NT) { const int i = u >> 4, ch = u & 15, lg = i >> 6, p = i & 63;
        const float dt = expf(log_dt[lg]); const float lr = a_re[i], li = a_im[i];
        const float mag = expf(lr * dt); float cs_, sn_; sincos_acc(li * dt, cs_, sn_);
        const float abr = mag * cs_, abi = mag * sn_; const float den = lr * lr + li * li;
        const float fr = ((abr - 1.0f) * lr + abi * li) / den, fi = (abi * lr - (abr - 1.0f) * li) / den;
        if (ch == 0) { AB[i] = (f32x2){abr, abi};
            float pr = abr, pi = abi;
#pragma unroll
            for (int q = 0; q < 5; ++q) { const float nr = pr * pr - pi * pi, ni = 2.0f * pr * pi; pr = nr; pi = ni; }
            A32[i] = (f32x2){pr, pi}; }
        { const float br = b_re[(size_t)i * 16 + ch], bi = b_im[(size_t)i * 16 + ch];
            BB[((size_t)lg * 128 + p) * 16 + ch] = (bf16)f2bf(fr * br - fi * bi); BB[((size_t)lg * 128 + 64 + p) * 16 + ch] = (bf16)f2bf(fr * bi + fi * br); }
        { CM[((size_t)lg * 16 + ch) * 128 + p] = (bf16)f2bf(c_re[((size_t)lg * 16 + ch) * 64 + p]); CM[((size_t)lg * 16 + ch) * 128 + 64 + p] = (bf16)f2bf(-c_im[((size_t)lg * 16 + ch) * 64 + p]); }
      } }
    LAS float* scr = (LAS float*)(lds + wave * 16384);
    const int gw = vcu * NWAVES + wave, NGW = G * NWAVES;
    for (int it = gw; it < DEPTH * I_LAYER; it += NGW) { const int l = it / I_LAYER, r = it % I_LAYER; if (tr_deferred(l, r)) continue; tr_dispatch(a, ws, l, r, scr, lane); }
}

__device__ __forceinline__ void phase_p0b(const Args& a, unsigned char* ws, LAS unsigned char* lds, int vcu, int G, int tid, int wave, int lane) {
    const bf16* SC = (const bf16*)(ws + WS_SC); float* MOD = (float*)(ws + WS_MOD);
    LAS f32x4* RED = (LAS f32x4*)lds;
    const int ch = wave & 1, kq = wave >> 1, j = lane & 15, kg = lane >> 4;
    (void)G;
    { const int it = vcu;
        const int l = it / (NMOD / 96), n0 = 96 * (it % (NMOD / 96)) + 48 * ch;
        const float* W = a.in[9] + (size_t)l * DM * NMOD;
        f32x4 acc[9][3];
#pragma unroll
        for (int rb = 0; rb < 9; ++rb)
#pragma unroll
            for (int cb = 0; cb < 3; ++cb) acc[rb][cb] = (f32x4){0.f, 0.f, 0.f, 0.f};
        f32x3a wv[8];
        { const float* wp = W + (size_t)(512 * kq + 8 * kg) * NMOD + n0 + 3 * j;
#pragma unroll
          for (int q = 0; q < 8; ++q) wv[q] = __builtin_nontemporal_load((const f32x3a*)(wp + (size_t)q * NMOD)); }
#pragma unroll 1
        for (int ks = 0; ks < 16; ++ks) {
            const int k0 = 512 * kq + 32 * ks;
            bf16x8 Xf[9], Y[3];
#pragma unroll
            for (int rb = 0; rb < 9; ++rb) Xf[rb] = *(const bf16x8*)(SC + (size_t)(16 * rb + j) * DM + k0 + 8 * kg);
#pragma unroll
            for (int cb = 0; cb < 3; ++cb) {
                v4u yb; yb.x = pk2(wv[0][cb], wv[1][cb]); yb.y = pk2(wv[2][cb], wv[3][cb]); yb.z = pk2(wv[4][cb], wv[5][cb]); yb.w = pk2(wv[6][cb], wv[7][cb]); Y[cb] = __builtin_bit_cast(bf16x8, yb); }
            asm volatile("" : "+v"(Y[0]), "+v"(Y[1]), "+v"(Y[2]));
            if (ks + 1 < 16) { const float* wp = W + (size_t)(k0 + 32 + 8 * kg) * NMOD + n0 + 3 * j;
#pragma unroll
                for (int q = 0; q < 8; ++q) wv[q] = __builtin_nontemporal_load((const f32x3a*)(wp + (size_t)q * NMOD)); }
#pragma unroll
            for (int rb = 0; rb < 9; ++rb)
#pragma unroll
                for (int cb = 0; cb < 3; ++cb) acc[rb][cb] = MFMA16(Xf[rb], Y[cb], acc[rb][cb]);
        }
#pragma unroll
        for (int rb = 0; rb < 9; ++rb) SETTLE4(acc[rb][0], acc[rb][1], acc[rb][2], acc[rb][2]);
        if (kq >= 2) {
#pragma unroll
            for (int rb = 0; rb < 9; ++rb)
#pragma unroll
                for (int cb = 0; cb < 3; ++cb) RED[(((kq - 2) * 2 + ch) * 27 + rb * 3 + cb) * 64 + lane] = acc[rb][cb]; }
        __syncthreads();
        if (kq < 2) {
#pragma unroll
            for (int rb = 0; rb < 9; ++rb)
#pragma unroll
                for (int cb = 0; cb < 3; ++cb) acc[rb][cb] += RED[((kq * 2 + ch) * 27 + rb * 3 + cb) * 64 + lane]; }
        __syncthreads();
        if (kq == 1) {
#pragma unroll
            for (int rb = 0; rb < 9; ++rb)
#pragma unroll
                for (int cb = 0; cb < 3; ++cb) RED[(ch * 27 + rb * 3 + cb) * 64 + lane] = acc[rb][cb]; }
        __syncthreads();
        if (kq == 0) {
#pragma unroll
            for (int cb = 0; cb < 3; ++cb) { const float bias = a.in[10][(size_t)l * NMOD + n0 + 3 * j + cb];
#pragma unroll
                for (int rb = 0; rb < 9; ++rb) { const f32x4 sres = acc[rb][cb] + RED[(ch * 27 + rb * 3 + cb) * 64 + lane];
#pragma unroll
                    for (int r = 0; r < 4; ++r) { const int row = 16 * rb + 4 * kg + r; if (row < NCOND) MOD[((size_t)l * NCOND + row) * NMOD + n0 + 3 * j + cb] = sres[r] + bias; } } }
        }
        __syncthreads();
    }
}

__device__ __forceinline__ void load_row(const float* xp, const float* xs, const float* slab, const float* gate  , float* Xout, int m, int lane, f32x4 (&v)[8]) {
    const float* xr = (m < MP) ? xp + (size_t)m * DM : xs + (size_t)(m - MP) * DM;
    const f32x4* x4 = (const f32x4*)xr + lane;
#pragma unroll
    for (int q = 0; q < 8; ++q) v[q] = x4[64 * q];
    if (slab && m >= MP) {
        const f32x4* g4 = (const f32x4*)(gate + (size_t)(PB + ((m - MP) >> 3)) * NMOD) + lane;
        const v2u* s2 = (const v2u*)((const bf16*)slab + (size_t)(m - MP) * DM) + lane;
#pragma unroll
        for (int qh = 0; qh < 2; ++qh) { v2u t[4][8];
#pragma unroll
            for (int e = 0; e < 4; ++e)
#pragma unroll
                for (int p = 0; p < 8; ++p) t[e][p] = __builtin_nontemporal_load(s2 + (size_t)p * (MS * DM / 4) + 64 * (4 * qh + e));
#pragma unroll
            for (int e = 0; e < 4; ++e) { const int q = 4 * qh + e; f32x4 sum = (f32x4){0.f, 0.f, 0.f, 0.f};
#pragma unroll
                for (int p = 0; p < 8; ++p) sum += (f32x4){bflo(t[e][p].x), bfhi(t[e][p].x), bflo(t[e][p].y), bfhi(t[e][p].y)};
                v[q] += g4[64 * q] * sum; ((f32x4*)(Xout + (size_t)m * DM) + lane)[64 * q] = v[q]; } }
    }
}
__device__ __forceinline__ int norm_rows(bool balanced, int vcu, int wave) { return balanced ? (wave < 4 ? 1 : 8) : 5; }
__device__ __forceinline__ int norm_row(bool balanced, int vcu, int G, int wave, int i) {
    if (balanced) return wave < 4 ? MP + vcu * 4 + wave : (vcu * 4 + wave - 4) * 8 + i;
    return vcu * NWAVES + wave + i * (G * NWAVES); }
__device__ __forceinline__ void phase_norm(const float* xp, const float* xs, const float* slab, const float* gate, float* Xout, const float* gamma, const float* modl, int sh_off, int sc_off, bf16* H, int vcu, int G, int wave, int lane) {
    const bool bal = slab != nullptr && G == 256; const int nr = norm_rows(bal, vcu, wave);
    int m = norm_row(bal, vcu, G, wave, 0); if (m >= MT) return;
    f32x4 v[8], A[8], Sh[8]; int cur_b = -1;
    load_row(xp, xs, slab, gate, Xout, m, lane, v);
#pragma unroll 1
    for (int i = 0; i < nr; ++i) {
        const int mn = (i + 1 < nr) ? norm_row(bal, vcu, G, wave, i + 1) : MT; const bool hn = mn < MT;
        f32x4 vn[8];
#pragma unroll
        for (int q = 0; q < 8; ++q) vn[q] = v[q];
        if (hn) load_row(xp, xs, nullptr, gate, Xout, mn, lane, vn);
        const int bidx = (m < MP) ? (m >> 11) : PB + ((m - MP) >> 3);
        if (bidx != cur_b) { cur_b = bidx;
            const f32x4* g4 = (const f32x4*)gamma + lane; const f32x4* sc4 = (const f32x4*)(modl + (size_t)bidx * NMOD + sc_off) + lane; const f32x4* sh4 = (const f32x4*)(modl + (size_t)bidx * NMOD + sh_off) + lane;
#pragma unroll
            for (int q = 0; q < 8; ++q) { A[q] = g4[64 * q] * (sc4[64 * q] + 1.0f); Sh[q] = sh4[64 * q]; } }
        float ss = 0.f;
#pragma unroll
        for (int q = 0; q < 8; ++q) ss += (v[q].x * v[q].x + v[q].y * v[q].y) + (v[q].z * v[q].z + v[q].w * v[q].w);
        const float r = 1.0f / sqrtf(wave_sum(ss, lane) * (1.0f / DM) + EPS);
        v2u* o = (v2u*)(H + (size_t)m * DM) + lane;
#pragma unroll
        for (int q = 0; q < 8; ++q) { const f32x4 y = (v[q] * r) * A[q] + Sh[q]; v2u w; w.x = pk2(y.x, y.y); w.y = pk2(y.z, y.w); o[64 * q] = w; }
        if (!hn) break;
#pragma unroll
        for (int q = 0; q < 8; ++q) v[q] = vn[q];
        m = mn;
    }
}
__device__ __forceinline__ void phase_final_norm(float* X, const float* slab, const float* gate, const float* gamma, float* out, int vcu, int G, int wave, int lane) {
    const bool bal = slab != nullptr && G == 256; const int nr = norm_rows(bal, vcu, wave);
    int m = norm_row(bal, vcu, G, wave, 0); if (m >= MT) return;
    f32x4 v[8], Gm[8];
#pragma unroll
    for (int q = 0; q < 8; ++q) Gm[q] = ((const f32x4*)gamma + lane)[64 * q];
    load_row(X, X + (size_t)MP * DM, slab, gate, X, m, lane, v);
#pragma unroll 1
    for (int i = 0; i < nr; ++i) {
        const int mn = (i + 1 < nr) ? norm_row(bal, vcu, G, wave, i + 1) : MT; const bool hn = mn < MT;
        f32x4 vn[8];
#pragma unroll
        for (int q = 0; q < 8; ++q) vn[q] = v[q];
        if (hn) load_row(X, X + (size_t)MP * DM, nullptr, gate, X, mn, lane, vn);
        float ss = 0.f;
#pragma unroll
        for (int q = 0; q < 8; ++q) ss += (v[q].x * v[q].x + v[q].y * v[q].y) + (v[q].z * v[q].z + v[q].w * v[q].w);
        const float r = 1.0f / sqrtf(wave_sum(ss, lane) * (1.0f / DM) + EPS);
        f32x4* o = (f32x4*)(out + (size_t)m * DM) + lane;
#pragma unroll
        for (int q = 0; q < 8; ++q) __builtin_nontemporal_store((v[q] * r) * Gm[q], o + 64 * q);
        if (!hn) break;
#pragma unroll
        for (int q = 0; q < 8; ++q) v[q] = vn[q];
        m = mn;
    }
}

constexpr int LDT = 136;
__device__ __forceinline__ void rot16(const bf16* src  , const f32x2* rope  , int d0, float scale, float (&o1)[16], float (&o2)[16]) {
    const v4u a0 = *(const v4u*)(src + d0), a1 = *(const v4u*)(src + d0 + 8), b0 = *(const v4u*)(src + 64 + d0), b1 = *(const v4u*)(src + 64 + d0 + 8);
    const unsigned aw[8] = {a0.x, a0.y, a0.z, a0.w, a1.x, a1.y, a1.z, a1.w}, bw[8] = {b0.x, b0.y, b0.z, b0.w, b1.x, b1.y, b1.z, b1.w};
#pragma unroll
    for (int i = 0; i < 16; ++i) { const float x1 = (i & 1) ? bfhi(aw[i >> 1]) : bflo(aw[i >> 1]), x2 = (i & 1) ? bfhi(bw[i >> 1]) : bflo(bw[i >> 1]);
        const f32x2 cs = rope[d0 + i]; o1[i] = (x1 * cs.x - x2 * cs.y) * scale; o2[i] = (x1 * cs.y + x2 * cs.x) * scale; }
}
__device__ __forceinline__ void kv_item(const bf16* PROJ, const f32x2* ROPEP, float* KV, LAS unsigned char* lds, int item, int tid, int wave, int lane) {
    const int h = item & 7, n = (item >> 3) & 15, b = item >> 7;
    LAS bf16* KT = (LAS bf16*)lds; LAS bf16* VT = KT + 128 * LDT;
    const int tok = tid & 127, s = tid >> 7; const int row = b * PSEQ + n * 128 + tok;
    const bf16* prow = PROJ + (size_t)row * DIN;
    const float lg = ret_lg(h);
    { float o1[16], o2[16]; rot16(prow + C_K + h * HD, ROPEP + (size_t)(n * 128 + tok) * 64, 16 * s, 0.08838834764831845f * __expf((float)(127 - tok) * lg), o1, o2);
#pragma unroll
      for (int i = 0; i < 16; ++i) { KT[(16 * s + i) * LDT + tok] = (bf16)f2bf(o1[i]); KT[(64 + 16 * s + i) * LDT + tok] = (bf16)f2bf(o2[i]); } }
    { const bf16* vp = prow + C_V + h * HD + 32 * s;
#pragma unroll
      for (int q = 0; q < 4; ++q) { const v4u w = *(const v4u*)(vp + 8 * q); const unsigned ww[4] = {w.x, w.y, w.z, w.w};
#pragma unroll
          for (int i = 0; i < 4; ++i) { VT[(32 * s + 8 * q + 2 * i) * LDT + tok] = (bf16)(ww[i] & 0xffffu); VT[(32 * s + 8 * q + 2 * i + 1) * LDT + tok] = (bf16)(ww[i] >> 16); } } }
    __syncthreads();
    const int j = lane & 15, kg = lane >> 4;
    f32x4 acc[8];
#pragma unroll
    for (int cb = 0; cb < 8; ++cb) acc[cb] = (f32x4){0.f, 0.f, 0.f, 0.f};
#pragma unroll
    for (int ks = 0; ks < 4; ++ks) { const bf16x8 X = *(const LAS bf16x8*)(VT + (16 * wave + j) * LDT + 32 * ks + 8 * kg);
#pragma unroll
        for (int cb = 0; cb < 8; ++cb) { const bf16x8 Y = *(const LAS bf16x8*)(KT + (16 * cb + j) * LDT + 32 * ks + 8 * kg); acc[cb] = MFMA16(X, Y, acc[cb]); } }
    SETTLE8(acc);
    float* kvo = KV + (size_t)((b * NH + h) * NCHUNK + n) * 128 * 128;
#pragma unroll
    for (int cb = 0; cb < 8; ++cb)
#pragma unroll
        for (int r = 0; r < 4; ++r) kvo[(size_t)(16 * wave + 4 * kg + r) * 128 + 16 * cb + j] = acc[cb][r];
    __syncthreads();
}

constexpr int DRV_LD = 20;
constexpr int SSM_WREG = 128 * DRV_LD * 4;
constexpr int HS_LD = 136;
constexpr int YA_LD = 520;
template <int PASS>
__device__ __forceinline__ void ssm_block(const Args& a, unsigned char* ws, int l, int blk  , LAS unsigned char* lds, int wave, int lane) {
    const bf16* PROJ = (const bf16*)(ws + WS_R1 + R1_PROJ);
    const f32x2* AB = (const f32x2*)(ws + WS_SAB) + (size_t)l * NG * NST; const bf16* BB = (const bf16*)(ws + WS_SBB) + (size_t)l * NG * 128 * 16; const bf16* CM = (const bf16*)(ws + WS_SCM) + (size_t)l * NG * 16 * 128;
    const int row0 = blk * 32; const bool sample = row0 >= MP;
    LAS float* DRV = (LAS float*)(lds + wave * SSM_WREG);
    LAS bf16* YA = (LAS bf16*)(lds + NWAVES * SSM_WREG);
    const int j = lane & 15, kg = lane >> 4, p = lane;
    const float* dsk = a.in[20] + (size_t)l * D_SSM;
#pragma unroll 1
    for (int gi = 0; gi < 4; ++gi) {
        const int g = wave * 4 + gi;
        bf16x8 Yb[8], Yc[4];
#pragma unroll
        for (int cb = 0; cb < 8; ++cb) { Yb[cb] = (bf16x8){0, 0, 0, 0, 0, 0, 0, 0}; if (kg < 2) Yb[cb] = *(const bf16x8*)(BB + ((size_t)g * 128 + 16 * cb + j) * 16 + 8 * kg); }
        if (PASS == 2) {
#pragma unroll
            for (int ks = 0; ks < 4; ++ks) Yc[ks] = *(const bf16x8*)(CM + ((size_t)g * 16 + j) * 128 + 32 * ks + 8 * kg);
        }
        const f32x2 ab = AB[g * NST + p];
        const float dk = (PASS == 2) ? dsk[g * 16 + j] : 0.f;
        float hr = 0.f, hi = 0.f;
        if (PASS == 2 && !sample) { const int b = row0 >> 11, bk = (row0 & 2047) >> 5; const f32x2 hin = ((const f32x2*)(ws + WS_HIN))[((size_t)(b * NBLK + bk) * NG + g) * NST + p]; hr = hin.x; hi = hin.y; }
        bf16x8 Xn = (bf16x8){0, 0, 0, 0, 0, 0, 0, 0}; if (kg < 2) Xn = *(const bf16x8*)(PROJ + (size_t)(row0 + j) * DIN + C_UA + g * 16 + 8 * kg);
#pragma unroll 1
        for (int sub = 0; sub < 2; ++sub) {
            const int r0 = row0 + 16 * sub;
            const bf16x8 X = Xn;
            if (sub == 0) { Xn = (bf16x8){0, 0, 0, 0, 0, 0, 0, 0}; if (kg < 2) Xn = *(const bf16x8*)(PROJ + (size_t)(row0 + 16 + j) * DIN + C_UA + g * 16 + 8 * kg); }
            float us[4] = {0.f, 0.f, 0.f, 0.f}; float h0r[2] = {0.f, 0.f}, h0i[2] = {0.f, 0.f};
            if (PASS == 2) {
#pragma unroll
                for (int r = 0; r < 4; ++r) us[r] = bf2f(PROJ[(size_t)(r0 + 4 * kg + r) * DIN + C_UA + g * 16 + j]);
                if (sample) {
#pragma unroll
                    for (int q = 0; q < 2; ++q) { const int seq = ((r0 - MP) >> 3) + q; const size_t si = (((size_t)l * SB + seq) * NG + g) * NST + p; h0r[q] = a.in[2][si]; h0i[q] = a.in[3][si]; } }
            }
            f32x4 dd[8];
#pragma unroll
            for (int cb = 0; cb < 8; ++cb) dd[cb] = MFMA16(X, Yb[cb], ((f32x4){0.f, 0.f, 0.f, 0.f}));
            SETTLE8(dd);
#pragma unroll
            for (int cb = 0; cb < 8; ++cb) *(LAS f32x4*)(DRV + (16 * cb + j) * DRV_LD + 4 * kg) = dd[cb];
            CFENCE();
            float dr[16], di[16];
#pragma unroll
            for (int t4 = 0; t4 < 4; ++t4) { const f32x4 vr = *(const LAS f32x4*)(DRV + p * DRV_LD + 4 * t4), vi = *(const LAS f32x4*)(DRV + (64 + p) * DRV_LD + 4 * t4);
                dr[4 * t4] = vr.x; dr[4 * t4 + 1] = vr.y; dr[4 * t4 + 2] = vr.z; dr[4 * t4 + 3] = vr.w; di[4 * t4] = vi.x; di[4 * t4 + 1] = vi.y; di[4 * t4 + 2] = vi.z; di[4 * t4 + 3] = vi.w; }
            CFENCE();
#pragma unroll
            for (int t = 0; t < 16; ++t) {
                if (PASS == 2 && sample && (t & 7) == 0) { hr = h0r[t >> 3]; hi = h0i[t >> 3]; }
                const float nr = ab.x * hr - ab.y * hi + dr[t], ni = ab.x * hi + ab.y * hr + di[t]; hr = nr; hi = ni;
                if (PASS == 2) { LAS bf16* hb = (LAS bf16*)DRV + t * HS_LD; { const unsigned hw = pk2(hr, hi); hb[p] = (bf16)(hw & 0xffffu); hb[64 + p] = (bf16)(hw >> 16); }
                    if (sample && (t & 7) == 7) { const int seq = (r0 + t - MP) >> 3; const size_t si = (((size_t)l * SB + seq) * NG + g) * NST + p; a.out[O_SRE + si] = hr; a.out[O_SIM + si] = hi; } }
            }
            if (PASS == 2) {
                CFENCE();
                f32x4 y = (f32x4){0.f, 0.f, 0.f, 0.f};
#pragma unroll
                for (int ks = 0; ks < 4; ++ks) { const bf16x8 Xh = *(const LAS bf16x8*)((LAS bf16*)DRV + j * HS_LD + 32 * ks + 8 * kg); y = MFMA16(Xh, Yc[ks], y); }
                SETTLE1(y);
#pragma unroll
                for (int r = 0; r < 4; ++r) YA[(16 * sub + 4 * kg + r) * YA_LD + g * 16 + j] = (bf16)f2bf(gelu_tanh(y[r] + dk * us[r]));
                CFENCE();
            }
        }
        if (PASS == 1) { const int b = row0 >> 11, bk = (row0 & 2047) >> 5; ((f32x2*)(ws + WS_E))[((size_t)(b * NBLK + bk) * NG + g) * NST + p] = (f32x2){hr, hi}; }
    }
}

__device__ __forceinline__ void sret_item(const Args& a, unsigned char* ws, int l, int item, LAS unsigned char* lds, int tid, int wave, int lane) {
    const bf16* PROJ = (const bf16*)(ws + WS_R1 + R1_PROJ); bf16* MIX = (bf16*)(ws + WS_R1 + R1_MIX); const f32x2* ROPES = (const f32x2*)(ws + WS_ROPES);
    const int h = item & 7, b = item >> 3; const int rowb = MP + b * SSEQ;
    LAS float* QS = (LAS float*)lds;
    LAS float* KS = QS + 1024;
    LAS float* QR = KS + 1024;
    LAS float* KR = QR + 1024;
    LAS float* VS = KR + 1024;
    LAS float* SCS = VS + 1024;
    LAS float* ORED = SCS + 64;
    const float lg = ret_lg(h);
    { const int t = tid >> 6, d = tid & 63; const bf16* pr = PROJ + (size_t)(rowb + t) * DIN; const f32x2 cs = ROPES[t * 64 + d];
      const float q1 = bf2f(pr[C_Q + h * HD + d]), q2 = bf2f(pr[C_Q + h * HD + 64 + d]), k1 = bf2f(pr[C_K + h * HD + d]), k2 = bf2f(pr[C_K + h * HD + 64 + d]);
      const float qa = q1 * cs.x - q2 * cs.y, qb = q1 * cs.y + q2 * cs.x, ka = (k1 * cs.x - k2 * cs.y) * 0.08838834764831845f, kb = (k1 * cs.y + k2 * cs.x) * 0.08838834764831845f;
      const float qd = __expf((float)(t + 1) * lg), kd = __expf((float)(7 - t) * lg);
      QS[d * 8 + t] = qa * qd; QS[(64 + d) * 8 + t] = qb * qd; KS[d * 8 + t] = ka * kd; KS[(64 + d) * 8 + t] = kb * kd;
      QR[t * 128 + d] = qa; QR[t * 128 + 64 + d] = qb; KR[t * 128 + d] = ka; KR[t * 128 + 64 + d] = kb;
      const unsigned vw = *(const unsigned*)(pr + C_V + h * HD + 2 * d); VS[t * 128 + 2 * d] = bflo(vw); VS[t * 128 + 2 * d + 1] = bfhi(vw); }
    __syncthreads();
    if (tid < 64) { const int i = tid >> 3, jj = tid & 7; float s = 0.f;
        for (int d = 0; d < 128; ++d) s += QR[i * 128 + d] * KR[jj * 128 + d];
        SCS[tid] = (i >= jj) ? s * __expf((float)(i - jj) * lg) : 0.f; }
    const int e4 = tid & 31, dg = tid >> 5;
    f32x4 vv[8];
#pragma unroll
    for (int t = 0; t < 8; ++t) vv[t] = *(const LAS f32x4*)(VS + t * 128 + 4 * e4);
    f32x4 oacc[8];
#pragma unroll
    for (int t = 0; t < 8; ++t) oacc[t] = (f32x4){0.f, 0.f, 0.f, 0.f};
    const float cdec = __expf(8.0f * lg);
    const float* S0 = a.in[4] + ((size_t)(l * SB + b) * NH + h) * HD * HD; float* S1 = a.out + O_SRET + ((size_t)(l * SB + b) * NH + h) * HD * HD;
    f32x4 s4[8];
#pragma unroll
    for (int r = 0; r < 8; ++r) s4[r] = __builtin_nontemporal_load((const f32x4*)(S0 + (size_t)(dg + 16 * r) * HD + 4 * e4));
#pragma unroll
    for (int r = 0; r < 8; ++r) { const int d = dg + 16 * r;
        const f32x4 qa = *(const LAS f32x4*)(QS + d * 8), qb = *(const LAS f32x4*)(QS + d * 8 + 4), ka = *(const LAS f32x4*)(KS + d * 8), kb = *(const LAS f32x4*)(KS + d * 8 + 4);
        const float qq[8] = {qa.x, qa.y, qa.z, qa.w, qb.x, qb.y, qb.z, qb.w}, kk[8] = {ka.x, ka.y, ka.z, ka.w, kb.x, kb.y, kb.z, kb.w};
        f32x4 sn = s4[r] * cdec;
#pragma unroll
        for (int t = 0; t < 8; ++t) { oacc[t] += s4[r] * qq[t]; sn += vv[t] * kk[t]; }
        __builtin_nontemporal_store(sn, (f32x4*)(S1 + (size_t)d * HD + 4 * e4)); }
#pragma unroll
    for (int t = 0; t < 8; ++t) *(LAS f32x4*)(ORED + (dg * 8 + t) * 128 + 4 * e4) = oacc[t];
    __syncthreads();
    { const int t = wave, e0 = 2 * lane; float o0 = 0.f, o1 = 0.f;
#pragma unroll
      for (int q = 0; q < 16; ++q) { const f32x2 v = *(const LAS f32x2*)(ORED + (q * 8 + t) * 128 + e0); o0 += v.x; o1 += v.y; }
#pragma unroll
      for (int jj = 0; jj < 8; ++jj) { const float sc = SCS[t * 8 + jj]; o0 += sc * VS[jj * 128 + e0]; o1 += sc * VS[jj * 128 + e0 + 1]; }
      const float mu = wave_sum(o0 + o1, lane) * (1.0f / 128.0f); const float d0 = o0 - mu, d1 = o1 - mu; const float var = wave_sum(d0 * d0 + d1 * d1, lane) * (1.0f / 128.0f); const float rs = 1.0f / sqrtf(var + EPS);
      const unsigned gw_ = *(const unsigned*)(PROJ + (size_t)(rowb + t) * DIN + C_G + h * HD + e0);
      *(unsigned*)(MIX + (size_t)(rowb + t) * DM + D_SSM + h * HD + e0) = pk2(d0 * rs * fsilu(bflo(gw_)), d1 * rs * fsilu(bfhi(gw_))); }
    __syncthreads();
}

__device__ __forceinline__ void phase_mixA2(const Args& a, unsigned char* ws, int l, int vcu, int G, int tid) {
    const int gt = vcu * NTHR + tid, NT = G * NTHR;
    const float* KV = (const float*)(ws + WS_R1 + R1_KV); bf16* SPT = (bf16*)(ws + WS_R1 + R1_SPT);
    for (int i = gt; i < PB * NH * 128 * 16; i += NT) { const int d8 = i & 15, e = (i >> 4) & 127, bh = i >> 11; const int h = bh & 7;
        const float cdec = __expf(128.0f * ret_lg(h)); float S[8];
#pragma unroll
        for (int q = 0; q < 8; ++q) S[q] = 0.f;
#pragma unroll 1
        for (int nb = 0; nb < NCHUNK; nb += 8) {
            f32x4 k0[8], k1[8];
#pragma unroll
            for (int n = 0; n < 8; ++n) { const float* kp = KV + (size_t)(bh * NCHUNK + nb + n) * 128 * 128 + (size_t)e * 128 + 8 * d8; k0[n] = *(const f32x4*)kp; k1[n] = *(const f32x4*)(kp + 4); }
#pragma unroll
            for (int n = 0; n < 8; ++n) { const size_t base = (size_t)(bh * NCHUNK + nb + n) * 128 * 128;
                v4u w; w.x = pk2(S[0], S[1]); w.y = pk2(S[2], S[3]); w.z = pk2(S[4], S[5]); w.w = pk2(S[6], S[7]);
                *(v4u*)(SPT + base + (size_t)e * 128 + 8 * d8) = w;
                S[0] = cdec * S[0] + k0[n].x; S[1] = cdec * S[1] + k0[n].y; S[2] = cdec * S[2] + k0[n].z; S[3] = cdec * S[3] + k0[n].w;
                S[4] = cdec * S[4] + k1[n].x; S[5] = cdec * S[5] + k1[n].y; S[6] = cdec * S[6] + k1[n].z; S[7] = cdec * S[7] + k1[n].w; } }
        float* po = a.out + O_PRET + ((size_t)l * PB * NH + bh) * HD * HD;
#pragma unroll
        for (int q = 0; q < 8; ++q) po[(size_t)(8 * d8 + q) * HD + e] = S[q]; }
    const f32x2* A32 = (const f32x2*)(ws + WS_SA32) + (size_t)l * NG * NST; const f32x2* E = (const f32x2*)(ws + WS_E); f32x2* HIN = (f32x2*)(ws + WS_HIN);
    for (int i = gt - (NT - PB * NG * NST); i >= 0 && i < PB * NG * NST; i += NT) { const int gp = i & (NG * NST - 1), b = i >> 11; const f32x2 aa = A32[gp]; float hr = 0.f, hi = 0.f;
#pragma unroll 1
        for (int kb = 0; kb < NBLK; kb += 32) {
            f32x2 ev[32];
#pragma unroll
            for (int k = 0; k < 32; ++k) ev[k] = E[(size_t)(b * NBLK + kb + k) * NG * NST + gp];
#pragma unroll
            for (int k = 0; k < 32; ++k) { HIN[(size_t)(b * NBLK + kb + k) * NG * NST + gp] = (f32x2){hr, hi};
                const float nr = aa.x * hr - aa.y * hi + ev[k].x, ni = aa.x * hi + aa.y * hr + ev[k].y; hr = nr; hi = ni; } }
        a.out[O_PRE + ((size_t)l * PB + b) * NG * NST + gp] = hr; a.out[O_PIM + ((size_t)l * PB + b) * NG * NST + gp] = hi; }
}

__device__ __forceinline__ void rope8(const v4u a, const v4u b, const f32x4 (&cs)[4], float scale, float (&r1)[8], float (&r2)[8]) {
    const unsigned aw[4] = {a.x, a.y, a.z, a.w}, bw[4] = {b.x, b.y, b.z, b.w};
#pragma unroll
    for (int i = 0; i < 8; ++i) { const float x1 = (i & 1) ? bfhi(aw[i >> 1]) : bflo(aw[i >> 1]), x2 = (i & 1) ? bfhi(bw[i >> 1]) : bflo(bw[i >> 1]);
        const float c = (i & 1) ? cs[i >> 1].z : cs[i >> 1].x, sn = (i & 1) ? cs[i >> 1].w : cs[i >> 1].y;
        r1[i] = (x1 * c - x2 * sn) * scale; r2[i] = (x1 * sn + x2 * c) * scale; }
}
__device__ __forceinline__ v4u pk8(const float (&r)[8]) { v4u w; w.x = pk2(r[0], r[1]); w.y = pk2(r[2], r[3]); w.z = pk2(r[4], r[5]); w.w = pk2(r[6], r[7]); return w; }
__device__ __forceinline__ void ret_item(const Args& a, unsigned char* ws, int item, LAS unsigned char* lds, int tid, int wave, int lane) {
    const bf16* PROJ = (const bf16*)(ws + WS_R1 + R1_PROJ); bf16* MIX = (bf16*)(ws + WS_R1 + R1_MIX); const f32x2* ROPEP = (const f32x2*)(ws + WS_ROPEP);
    const bf16* SPT = (const bf16*)(ws + WS_R1 + R1_SPT);
    const int h = item & 7, n = (item >> 3) & 15, b = item >> 7;
    LAS bf16* KS = (LAS bf16*)lds; LAS bf16* VT = KS + 128 * LDT; LAS bf16* SCW = VT + 128 * LDT + wave * 16 * LDT;
    const float lg = ret_lg(h);
    const int j = lane & 15, kg = lane >> 4;
    const int tok = tid & 127, s = tid >> 7; const bf16* prow = PROJ + (size_t)(b * PSEQ + n * 128 + tok) * DIN;
    const bf16* ksrc = prow + C_K + h * HD + 16 * s; const f32x4* krp = (const f32x4*)(ROPEP + (size_t)(n * 128 + tok) * 64 + 16 * s);
    const v4u ka0 = *(const v4u*)ksrc, ka1 = *(const v4u*)(ksrc + 8), kb0 = *(const v4u*)(ksrc + 64), kb1 = *(const v4u*)(ksrc + 72);
    f32x4 kc0[4], kc1[4];
#pragma unroll
    for (int i = 0; i < 4; ++i) { kc0[i] = krp[i]; kc1[i] = krp[4 + i]; }
    v4u vw[4];
#pragma unroll
    for (int q = 0; q < 4; ++q) vw[q] = *(const v4u*)(prow + C_V + h * HD + 32 * s + 8 * q);
    const int rowi = b * PSEQ + n * 128 + 16 * wave + j;
    const bf16* qp = PROJ + (size_t)rowi * DIN + C_Q + h * HD + 8 * kg; const f32x4* qrp = (const f32x4*)(ROPEP + (size_t)(n * 128 + 16 * wave + j) * 64 + 8 * kg);
    const v4u qa0 = *(const v4u*)qp, qa1 = *(const v4u*)(qp + 32), qb0 = *(const v4u*)(qp + 64), qb1 = *(const v4u*)(qp + 96);
    f32x4 qc0[4], qc1[4];
#pragma unroll
    for (int i = 0; i < 4; ++i) { qc0[i] = qrp[i]; qc1[i] = qrp[16 + i]; }
    const int gr = lane >> 2, gc = lane & 3;
    const size_t orow = (size_t)b * PSEQ + n * 128 + 16 * wave + gr;
    v4u gt[4];
#pragma unroll
    for (int i = 0; i < 4; ++i) gt[i] = *(const v4u*)(PROJ + orow * DIN + C_G + h * HD + 32 * gc + 8 * i);
    { float r1[8], r2[8];
      rope8(ka0, kb0, kc0, 0.08838834764831845f, r1, r2); *(LAS v4u*)(KS + tok * LDT + 16 * s) = pk8(r1); *(LAS v4u*)(KS + tok * LDT + 64 + 16 * s) = pk8(r2);
      rope8(ka1, kb1, kc1, 0.08838834764831845f, r1, r2); *(LAS v4u*)(KS + tok * LDT + 16 * s + 8) = pk8(r1); *(LAS v4u*)(KS + tok * LDT + 64 + 16 * s + 8) = pk8(r2);
#pragma unroll
      for (int q = 0; q < 4; ++q) { const unsigned ww[4] = {vw[q].x, vw[q].y, vw[q].z, vw[q].w};
#pragma unroll
          for (int i = 0; i < 4; ++i) { VT[(32 * s + 8 * q + 2 * i) * LDT + tok] = (bf16)(ww[i] & 0xffffu); VT[(32 * s + 8 * q + 2 * i + 1) * LDT + tok] = (bf16)(ww[i] >> 16); } } }
    bf16x8 XQ[4];
    { float r1[8], r2[8];
      rope8(qa0, qb0, qc0, 1.0f, r1, r2); XQ[0] = __builtin_bit_cast(bf16x8, pk8(r1)); XQ[2] = __builtin_bit_cast(bf16x8, pk8(r2));
      rope8(qa1, qb1, qc1, 1.0f, r1, r2); XQ[1] = __builtin_bit_cast(bf16x8, pk8(r1)); XQ[3] = __builtin_bit_cast(bf16x8, pk8(r2)); }
    __syncthreads();
    const bf16* spt = SPT + (size_t)((b * NH + h) * NCHUNK + n) * 128 * 128 + (size_t)j * 128 + 8 * kg;
    bf16x8 Ys[4][8];
#pragma unroll
    for (int ks = 0; ks < 2; ++ks)
#pragma unroll
        for (int eb = 0; eb < 8; ++eb) Ys[ks][eb] = *(const bf16x8*)(spt + (size_t)(16 * eb) * 128 + 32 * ks);
#pragma unroll
    for (int jb = 0; jb < 8; ++jb) { f32x4 sc = (f32x4){0.f, 0.f, 0.f, 0.f};
#pragma unroll
        for (int ks = 0; ks < 4; ++ks) { const bf16x8 Y = *(const LAS bf16x8*)(KS + (16 * jb + j) * LDT + 32 * ks + 8 * kg); sc = MFMA16(XQ[ks], Y, sc); }
        SETTLE1(sc);
#pragma unroll
        for (int r = 0; r < 4; ++r) { const int ii = 16 * wave + 4 * kg + r, jj = 16 * jb + j; const float m = (ii >= jj) ? __expf((float)(ii - jj) * lg) : 0.f; SCW[(4 * kg + r) * LDT + jj] = (bf16)f2bf(sc[r] * m); } }
    CFENCE();
#pragma unroll
    for (int ks = 2; ks < 4; ++ks)
#pragma unroll
        for (int eb = 0; eb < 8; ++eb) Ys[ks][eb] = *(const bf16x8*)(spt + (size_t)(16 * eb) * 128 + 32 * ks);
    f32x4 oi[8], ox[8];
#pragma unroll
    for (int eb = 0; eb < 8; ++eb) { oi[eb] = (f32x4){0.f, 0.f, 0.f, 0.f}; ox[eb] = (f32x4){0.f, 0.f, 0.f, 0.f}; }
#pragma unroll
    for (int ks = 0; ks < 4; ++ks) { const bf16x8 Xs = *(const LAS bf16x8*)(SCW + j * LDT + 32 * ks + 8 * kg);
#pragma unroll
        for (int eb = 0; eb < 8; ++eb) { const bf16x8 Yv = *(const LAS bf16x8*)(VT + (16 * eb + j) * LDT + 32 * ks + 8 * kg); oi[eb] = MFMA16(Xs, Yv, oi[eb]); } }
#pragma unroll
    for (int ks = 0; ks < 4; ++ks)
#pragma unroll
        for (int eb = 0; eb < 8; ++eb) ox[eb] = MFMA16(XQ[ks], Ys[ks][eb], ox[eb]);
    SETTLE8(oi); SETTLE8(ox);
    CFENCE();
#pragma unroll
    for (int r = 0; r < 4; ++r) { const int ii = 16 * wave + 4 * kg + r; const float qd = __expf((float)(ii + 1) * lg);
        float o[8]; float sm = 0.f;
#pragma unroll
        for (int eb = 0; eb < 8; ++eb) { o[eb] = oi[eb][r] + qd * ox[eb][r]; sm += o[eb]; }
        const float mu = sum16(sm, lane) * (1.0f / 128.0f); float q = 0.f;
#pragma unroll
        for (int eb = 0; eb < 8; ++eb) { o[eb] -= mu; q += o[eb] * o[eb]; }
        const float rs = 1.0f / sqrtf(sum16(q, lane) * (1.0f / 128.0f) + EPS);
#pragma unroll
        for (int eb = 0; eb < 8; ++eb) SCW[(4 * kg + r) * LDT + 16 * eb + j] = (bf16)f2bf(o[eb] * rs); }
    CFENCE();
#pragma unroll
    for (int i = 0; i < 4; ++i) { const v4u nv = *(const LAS v4u*)(SCW + gr * LDT + 32 * gc + 8 * i); const unsigned nw[4] = {nv.x, nv.y, nv.z, nv.w}, gw[4] = {gt[i].x, gt[i].y, gt[i].z, gt[i].w}; v4u ow; unsigned o4[4];
#pragma unroll
        for (int q = 0; q < 4; ++q) o4[q] = pk2(bflo(nw[q]) * fsilu(bflo(gw[q])), bfhi(nw[q]) * fsilu(bfhi(gw[q])));
        ow.x = o4[0]; ow.y = o4[1]; ow.z = o4[2]; ow.w = o4[3];
        *(v4u*)(MIX + orow * DM + D_SSM + h * HD + 32 * gc + 8 * i) = ow; }
    __syncthreads();
}

template <int W, int NOUT> __device__ __forceinline__ void pool_vals(const float (&val)[15 + NOUT], int pos0, bool prompt, LAS bf16* pl  ) {
#pragma unroll
    for (int i = 0; i < NOUT; ++i) { float s = 0.f;
#pragma unroll
        for (int q = W - 1; q >= 0; --q) s += val[15 + i - q];
        const int pc = pos0 + i + 1; const float m = (prompt && pc < W) ? s / (float)pc : s * (1.0f / (float)W); pl[i * YA_LD] = (bf16)f2bf(m - val[15 + i]); }
}
template <int PARTS  >
__device__ __forceinline__ void tok_item(const Args& a, unsigned char* ws, int l, int blk, LAS unsigned char* lds, int tid, int wave, int lane) {
    const bf16* PROJ = (const bf16*)(ws + WS_R1 + R1_PROJ); bf16* MIX = (bf16*)(ws + WS_R1 + R1_MIX);
    const bf16* wl = (const bf16*)(ws + WS_W + (size_t)l * W_LAYER);
    const int row0 = blk * 32; const bool sample = row0 >= MP;
    if (PARTS & 1) ssm_block<2>(a, ws, l, blk, lds, wave, lane);
    __syncthreads();
    LAS bf16* YA = (LAS bf16*)(lds + NWAVES * SSM_WREG);
    const int j = lane & 15, kg = lane >> 4;
    if (PARTS & 2) {
      const bf16* WG = (const bf16*)((const char*)wl + W_GLU);
      f32x4 acc[2][4];
#pragma unroll
      for (int rb = 0; rb < 2; ++rb)
#pragma unroll
          for (int cb = 0; cb < 4; ++cb) acc[rb][cb] = (f32x4){0.f, 0.f, 0.f, 0.f};
      const bf16* wgp = WG + (size_t)(64 * wave + j) * D_SSM + 8 * kg;
#define GLU_LOAD(Yd, kb) do { _Pragma("unroll") for (int q = 0; q < 4; ++q) _Pragma("unroll") for (int cb = 0; cb < 4; ++cb) Yd[q][cb] = *(const bf16x8*)(wgp + (size_t)(16 * cb) * D_SSM + 32 * (4 * (kb) + q)); } while (0)
#define GLU_MMA(Yd, kb) do { _Pragma("unroll") for (int q = 0; q < 4; ++q) { bf16x8 X[2]; _Pragma("unroll") for (int rb = 0; rb < 2; ++rb) X[rb] = *(const LAS bf16x8*)(YA + (16 * rb + j) * YA_LD + 32 * (4 * (kb) + q) + 8 * kg); \
          _Pragma("unroll") for (int cb = 0; cb < 4; ++cb) _Pragma("unroll") for (int rb = 0; rb < 2; ++rb) acc[rb][cb] = MFMA16(X[rb], Yd[q][cb], acc[rb][cb]); } } while (0)
      bf16x8 Y0[4][4], Y1[4][4];
      GLU_LOAD(Y0, 0); GLU_LOAD(Y1, 1); GLU_MMA(Y0, 0); GLU_LOAD(Y0, 2); GLU_MMA(Y1, 1); GLU_LOAD(Y1, 3); GLU_MMA(Y0, 2); GLU_MMA(Y1, 3);
#undef GLU_LOAD
#undef GLU_MMA
      SETTLE4(acc[0][0], acc[0][1], acc[0][2], acc[0][3]); SETTLE4(acc[1][0], acc[1][1], acc[1][2], acc[1][3]);
      const float* bg = a.in[22] + (size_t)l * D_SSM;
#pragma unroll
      for (int cb = 0; cb < 4; ++cb) { const int col = 64 * wave + 16 * cb + j; const float bias = bg[col];
#pragma unroll
          for (int rb = 0; rb < 2; ++rb)
#pragma unroll
              for (int r = 0; r < 4; ++r) { const int tk = 16 * rb + 4 * kg + r; const float ya = bf2f(YA[tk * YA_LD + col]); MIX[(size_t)(row0 + tk) * DM + col] = (bf16)f2bf(ya * fsigmoid(acc[rb][cb][r] + bias)); } } }
    __syncthreads();
    LAS bf16* PL = YA;
    if (PARTS & 4) { const int c = tid; const int gi = c >> 7;
      if (!sample) { const int b = row0 >> 11, t0 = row0 & 2047; float val[47];
#pragma unroll
          for (int k = 0; k < 47; ++k) { const int t = t0 - 15 + k; val[k] = (t >= 0) ? bf2f(PROJ[(size_t)(b * PSEQ + t) * DIN + C_UC + c]) : 0.f; }
          if (gi == 0) pool_vals<2, 32>(val, t0, true, PL + c); else if (gi == 1) pool_vals<4, 32>(val, t0, true, PL + c); else if (gi == 2) pool_vals<8, 32>(val, t0, true, PL + c); else pool_vals<16, 32>(val, t0, true, PL + c);
          if (t0 == PSEQ - 32) { float* po = a.out + O_PPOOL + ((size_t)(l * PB + b) * 15) * D_POOL + c;
#pragma unroll
              for (int q = 0; q < 15; ++q) po[(size_t)q * D_POOL] = val[32 + q]; }
      } else {
#pragma unroll 1
          for (int sq = 0; sq < 4; ++sq) { const int seq = ((row0 - MP) >> 3) + sq; float val[23];
              const float* sp = a.in[5] + ((size_t)(l * SB + seq) * 15) * D_POOL + c;
#pragma unroll
              for (int k = 0; k < 15; ++k) val[k] = sp[(size_t)k * D_POOL];
#pragma unroll
              for (int k = 0; k < 8; ++k) val[15 + k] = bf2f(PROJ[(size_t)(MP + seq * 8 + k) * DIN + C_UC + c]);
              LAS bf16* pls = PL + (8 * sq) * YA_LD + c;
              if (gi == 0) pool_vals<2, 8>(val, 0, false, pls); else if (gi == 1) pool_vals<4, 8>(val, 0, false, pls); else if (gi == 2) pool_vals<8, 8>(val, 0, false, pls); else pool_vals<16, 8>(val, 0, false, pls);
              float* po = a.out + O_SPOOL + ((size_t)(l * SB + seq) * 15) * D_POOL + c;
#pragma unroll
              for (int q = 0; q < 15; ++q) po[(size_t)q * D_POOL] = val[8 + q]; }
      } }
    __syncthreads();
#if DBG_CHECK
    { bf16* PLD = (bf16*)(ws + WS_END); for (int i = 0; i < 32; ++i) PLD[(size_t)(row0 + i) * D_POOL + tid] = PL[i * YA_LD + tid]; }
#endif
    if (PARTS & 4) {
      const int gi = wave >> 1, dh = wave & 1; const bf16* WP = (const bf16*)((const char*)wl + W_POOL) + (size_t)gi * 128 * 128;
      f32x4 acc[2][4];
#pragma unroll
      for (int rb = 0; rb < 2; ++rb)
#pragma unroll
          for (int cb = 0; cb < 4; ++cb) acc[rb][cb] = (f32x4){0.f, 0.f, 0.f, 0.f};
#pragma unroll
      for (int ks = 0; ks < 4; ++ks) { bf16x8 X[2];
#pragma unroll
          for (int rb = 0; rb < 2; ++rb) X[rb] = *(const LAS bf16x8*)(PL + (16 * rb + j) * YA_LD + gi * 128 + 32 * ks + 8 * kg);
#pragma unroll
          for (int cb = 0; cb < 4; ++cb) { const bf16x8 Y = *(const bf16x8*)(WP + (size_t)(64 * dh + 16 * cb + j) * 128 + 32 * ks + 8 * kg);
#pragma unroll
              for (int rb = 0; rb < 2; ++rb) acc[rb][cb] = MFMA16(X[rb], Y, acc[rb][cb]); } }
      SETTLE4(acc[0][0], acc[0][1], acc[0][2], acc[0][3]); SETTLE4(acc[1][0], acc[1][1], acc[1][2], acc[1][3]);
      const float* psc = a.in[24] + (size_t)l * D_POOL;
#pragma unroll
      for (int cb = 0; cb < 4; ++cb) { const int dcol = gi * 128 + 64 * dh + 16 * cb + j; const float sc = psc[dcol];
#pragma unroll
          for (int rb = 0; rb < 2; ++rb)
#pragma unroll
              for (int r = 0; r < 4; ++r) { const int tk = 16 * rb + 4 * kg + r; MIX[(size_t)(row0 + tk) * DM + D_SSM + D_RET + dcol] = (bf16)f2bf(acc[rb][cb][r] * sc); } } }
    __syncthreads();
}
__device__ __forceinline__ void phase_mixA(const Args& a, unsigned char* ws, int l, LAS unsigned char* lds, int vcu, int G, int tid, int wave, int, int qrep = 0) {
    const bf16* PROJ = (const bf16*)(ws + WS_R1 + R1_PROJ);
    constexpr int N_KV = PB * NCHUNK * NH, N_S1 = MP / 32, N_SR = SB * NH, N_TS = 2 * (MS / 32);
    const int tid_in = tid;
    unsigned* const qctr = (unsigned*)(ws + 8192) + 64 * (2 * l + 4 * qrep);
    volatile LAS int* const qslot = (volatile LAS int*)(lds + MISC_OFF + 64);
    (void)vcu; (void)G;
    for (;;) {
        int tid = tid_in; asm volatile("" : "+v"(tid)); const int lane = tid & 63;
        if (tid == 0) *qslot = (int)atomicAdd(qctr, 1u);
        __syncthreads();
        const int it = __builtin_amdgcn_readfirstlane(*qslot);
        if (it >= N_TS + N_KV + N_S1 + N_SR) break;
        if (it < N_TS / 2) tok_item<3>(a, ws, l, MP / 32 + it, lds, tid, wave, lane);
        else if (it < N_TS) tok_item<4>(a, ws, l, MP / 32 + it - N_TS / 2, lds, tid, wave, lane);
        else if (it < N_TS + N_KV) kv_item(PROJ, (const f32x2*)(ws + WS_ROPEP), (float*)(ws + WS_R1 + R1_KV), lds, it - N_TS, tid, wave, lane);
        else if (it < N_TS + N_KV + N_S1) { ssm_block<1>(a, ws, l, it - N_TS - N_KV, lds, wave, lane); __syncthreads(); }
        else sret_item(a, ws, l, it - N_TS - N_KV - N_S1, lds, tid, wave, lane);
    }
}

__device__ __forceinline__ void phase_mixB(const Args& a, unsigned char* ws, int l, LAS unsigned char* lds, int vcu, int G, int tid, int wave, int, int qrep = 0) {
    constexpr int N_R = PB * NCHUNK * NH, N_T = MP / 32;
    const int tid_in = tid;
    unsigned* const qctr = (unsigned*)(ws + 8192) + 64 * (2 * l + 1 + 4 * qrep);
    volatile LAS int* const qslot = (volatile LAS int*)(lds + MISC_OFF + 64);
    (void)vcu; (void)G;
    for (;;) {
        int tid = tid_in; asm volatile("" : "+v"(tid)); const int lane = tid & 63;
        if (tid == 0) *qslot = (int)atomicAdd(qctr, 1u);
        __syncthreads();
        const int it = __builtin_amdgcn_readfirstlane(*qslot);
        if (it >= N_R + N_T) break;
#ifndef SUBSEL
#define SUBSEL 3
#endif
        if (it < N_T) { if (SUBSEL & 2) tok_item<7>(a, ws, l, N_T - 1 - it, lds, tid, wave, lane); }
        else { if (SUBSEL & 1) ret_item(a, ws, it - N_T, lds, tid, wave, lane); }
    }
}

constexpr size_t WS_SLAB3 = WS_END, WS_HALO = WS_SLAB3 + (size_t)8 * 3072 * 256 * 4, WS_FIXA = WS_HALO + (size_t)64 * 2 * FF * 4, WS_FIXB = WS_FIXA + (size_t)64 * 2 * FF * 4, WS_END2 = WS_FIXB + (size_t)64 * 2 * FF * 4;
__device__ __forceinline__ void ld8(const float* p, float (&v)[8]) { const f32x4 x = *(const f32x4*)p, y = *(const f32x4*)(p + 4); v[0] = x.x; v[1] = x.y; v[2] = x.z; v[3] = x.w; v[4] = y.x; v[5] = y.y; v[6] = y.z; v[7] = y.w; }
__device__ __forceinline__ void slab_ab(const float* slab, int row, int sc, float (&av)[8], float (&bv)[8]) {
    f32x4 a0 = (f32x4){0.f, 0.f, 0.f, 0.f}, a1 = a0, b0 = a0, b1 = a0;
#pragma unroll
    for (int p = 0; p < 8; ++p) { const float* sp = slab + ((size_t)p * 3072 + (row - 6144)) * 256 + sc; a0 += *(const f32x4*)sp; a1 += *(const f32x4*)(sp + 4); b0 += *(const f32x4*)(sp + 128); b1 += *(const f32x4*)(sp + 132); }
    av[0] = a0.x; av[1] = a0.y; av[2] = a0.z; av[3] = a0.w; av[4] = a1.x; av[5] = a1.y; av[6] = a1.z; av[7] = a1.w; bv[0] = b0.x; bv[1] = b0.y; bv[2] = b0.z; bv[3] = b0.w; bv[4] = b1.x; bv[5] = b1.y; bv[6] = b1.z; bv[7] = b1.w;
}
__device__ __forceinline__ void act8(const float (&w0)[8], const float (&w1)[8], const float (&w2)[8], const float (&bb)[8], const float (&p2)[8], const float (&p1)[8], const float (&av)[8], const float (&bv)[8], bf16* dst) {
    float o[8];
#pragma unroll
    for (int q = 0; q < 8; ++q) o[q] = fsilu(bb[q] + w0[q] * p2[q] + w1[q] * p1[q] + w2[q] * av[q]) * bv[q];
    v4u w; w.x = pk2(o[0], o[1]); w.y = pk2(o[2], o[3]); w.z = pk2(o[4], o[5]); w.w = pk2(o[6], o[7]); *(v4u*)dst = w;
}
__device__ __forceinline__ void phase_actfix(const Args& a, unsigned char* ws, int l, int vcu, int G, int tid) {
    bf16* ACT = (bf16*)(ws + WS_ACT); const float* slab = (const float*)(ws + WS_SLAB3); const float* HALO = (const float*)(ws + WS_HALO); const float* FIXA = (const float*)(ws + WS_FIXA); const float* FIXB = (const float*)(ws + WS_FIXB);
    const float* cw = a.in[28] + (size_t)l * 3 * FF; const float* cbias = a.in[29] + (size_t)l * FF;
    const int gt = vcu * NTHR + tid, NT = G * NTHR; constexpr int NCG = FF / 8;
    for (int i = gt; i < 64 * 2 * NCG; i += NT) { const int cg = i % NCG, j = (i / NCG) & 1, blk = i / (2 * NCG), c0 = 8 * cg;
        if ((blk & 15) == 0 || (TAILSPLIT && c0 >= 42 * 128 && blk >= 48)) continue;
        float w0[8], w1[8], w2[8], bb[8], av[8], bv[8], p1[8], p2[8];
        ld8(cw + c0, w0); ld8(cw + FF + c0, w1); ld8(cw + 2 * FF + c0, w2); ld8(cbias + c0, bb);
        ld8(FIXA + ((size_t)blk * 2 + j) * FF + c0, av); ld8(FIXB + ((size_t)blk * 2 + j) * FF + c0, bv);
        if (j == 0) { ld8(HALO + ((size_t)(blk - 1) * 2 + 0) * FF + c0, p2); ld8(HALO + ((size_t)(blk - 1) * 2 + 1) * FF + c0, p1); }
        else { ld8(HALO + ((size_t)(blk - 1) * 2 + 1) * FF + c0, p2); ld8(FIXA + ((size_t)blk * 2 + 0) * FF + c0, p1); }
        act8(w0, w1, w2, bb, p2, p1, av, bv, ACT + (size_t)(128 * blk + j) * FF + c0); }
    for (int i = gt - (NT - PB * 2 * FF); i >= 0 && i < PB * 2 * FF; i += NT) { const int c = i % FF, j = (i / FF) & 1, b = i / (2 * FF); if (TAILSPLIT && c >= 42 * 128 && b == 3) continue;
        a.out[O_PCONV + ((size_t)(l * PB + b) * 2 + j) * FF + c] = HALO[((size_t)(16 * b + 15) * 2 + j) * FF + c]; }
    for (int i = gt; i < (TAILSPLIT ? 768 * 16 : 0); i += NT) { const int cg16 = i & 15, run4 = i >> 4, row0 = 6144 + 4 * run4, sc = 8 * cg16, c0 = 42 * 128 + sc; const bool sample = row0 >= MP;
        float w0[8], w1[8], w2[8], bb[8], av[8], bv[8], p1[8], p2[8], dm[8];
        ld8(cw + c0, w0); ld8(cw + FF + c0, w1); ld8(cw + 2 * FF + c0, w2); ld8(cbias + c0, bb);
        if (sample && (row0 & 7) == 0) { const int seq = (row0 - MP) >> 3; ld8(a.in[6] + ((size_t)(l * SB + seq) * 2 + 0) * FF + c0, p2); ld8(a.in[6] + ((size_t)(l * SB + seq) * 2 + 1) * FF + c0, p1); }
        else if (!sample && (row0 & 2047) == 0) {
#pragma unroll
            for (int q = 0; q < 8; ++q) { p1[q] = 0.f; p2[q] = 0.f; } }
        else { slab_ab(slab, row0 - 2, sc, p2, dm); slab_ab(slab, row0 - 1, sc, p1, dm); }
#pragma unroll 1
        for (int t = 0; t < 4; ++t) { const int row = row0 + t; slab_ab(slab, row, sc, av, bv);
            act8(w0, w1, w2, bb, p2, p1, av, bv, ACT + (size_t)row * FF + c0);
            if (sample) { if ((row & 7) >= 6) { float* so = a.out + O_SCONV + ((size_t)(l * SB + ((row - MP) >> 3)) * 2 + ((row & 7) - 6)) * FF + c0;
#pragma unroll
                    for (int q = 0; q < 8; ++q) so[q] = av[q]; } }
            else if ((row & 2047) >= PSEQ - 2) { float* po = a.out + O_PCONV + ((size_t)(l * PB + (row >> 11)) * 2 + ((row & 2047) - (PSEQ - 2))) * FF + c0;
#pragma unroll
                for (int q = 0; q < 8; ++q) po[q] = av[q]; }
#pragma unroll
            for (int q = 0; q < 8; ++q) { p2[q] = p1[q]; p1[q] = av[q]; } } }
}

__device__ __forceinline__ void phase_act(const Args& a, unsigned char* ws, int l, int vcu, int G, int tid) {
    const bf16* AB = (const bf16*)(ws + WS_R1); bf16* ACT = (bf16*)(ws + WS_ACT);
    const float* cw = a.in[28] + (size_t)l * 3 * FF; const float* cbias = a.in[29] + (size_t)l * FF;
    const int gt = vcu * NTHR + tid, NT = G * NTHR; constexpr int NCG = FF / 8;
    for (int i = gt; i < (MT / 32) * NCG; i += NT) {
        const int run = i / NCG, cg = i % NCG, c0 = 8 * cg; const int acol = 256 * (c0 >> 7) + (c0 & 127); const int row0 = run * 32;
        float w0[8], w1[8], w2[8], bb[8];
#pragma unroll
        for (int q = 0; q < 8; ++q) { w0[q] = cw[c0 + q]; w1[q] = cw[FF + c0 + q]; w2[q] = cw[2 * FF + c0 + q]; bb[q] = cbias[c0 + q]; }
        float am1[8], am2[8];
        const bool sample = row0 >= MP;
#pragma unroll
        for (int q = 0; q < 8; ++q) { am1[q] = 0.f; am2[q] = 0.f; }
        if (!sample && (row0 & 2047) != 0) { const v4u p1 = *(const v4u*)(AB + (size_t)(row0 - 1) * 2 * FF + acol), p2 = *(const v4u*)(AB + (size_t)(row0 - 2) * 2 * FF + acol);
            const unsigned u1[4] = {p1.x, p1.y, p1.z, p1.w}, u2[4] = {p2.x, p2.y, p2.z, p2.w};
#pragma unroll
            for (int q = 0; q < 4; ++q) { am1[2 * q] = bflo(u1[q]); am1[2 * q + 1] = bfhi(u1[q]); am2[2 * q] = bflo(u2[q]); am2[2 * q + 1] = bfhi(u2[q]); } }
#pragma unroll 4
        for (int t = 0; t < 32; ++t) { const int row = row0 + t;
            if (sample && (t & 7) == 0) { const int seq = (row - MP) >> 3; const float* st = a.in[6] + ((size_t)(l * SB + seq) * 2) * FF + c0;
#pragma unroll
                for (int q = 0; q < 8; ++q) { am2[q] = st[q]; am1[q] = st[FF + q]; } }
            const v4u av = *(const v4u*)(AB + (size_t)row * 2 * FF + acol), bv = *(const v4u*)(AB + (size_t)row * 2 * FF + acol + 128);
            const unsigned ua[4] = {av.x, av.y, av.z, av.w}, ub[4] = {bv.x, bv.y, bv.z, bv.w}; float o[8], ac[8];
#pragma unroll
            for (int q = 0; q < 8; ++q) { ac[q] = (q & 1) ? bfhi(ua[q >> 1]) : bflo(ua[q >> 1]); const float bq = (q & 1) ? bfhi(ub[q >> 1]) : bflo(ub[q >> 1]);
                const float cv = bb[q] + w0[q] * am2[q] + w1[q] * am1[q] + w2[q] * ac[q]; o[q] = fsilu(cv) * bq; am2[q] = am1[q]; am1[q] = ac[q]; }
            v4u w; w.x = pk2(o[0], o[1]); w.y = pk2(o[2], o[3]); w.z = pk2(o[4], o[5]); w.w = pk2(o[6], o[7]); *(v4u*)(ACT + (size_t)row * FF + c0) = w;
            if (sample) { if ((t & 7) >= 6) { const int seq = (row - MP) >> 3; float* so = a.out + O_SCONV + ((size_t)(l * SB + seq) * 2 + ((t & 7) - 6)) * FF + c0;
#pragma unroll
                    for (int q = 0; q < 8; ++q) so[q] = ac[q]; } }
            else if ((row & 2047) >= PSEQ - 2) { const int b = row >> 11; float* po = a.out + O_PCONV + ((size_t)(l * PB + b) * 2 + ((row & 2047) - (PSEQ - 2))) * FF + c0;
#pragma unroll
                for (int q = 0; q < 8; ++q) po[q] = ac[q]; }
        }
    }
}


#ifndef DBG_CHECK
#define DBG_CHECK 0
#endif
#if DBG_CHECK
__device__ __forceinline__ float bfr(float x) { return bf2f(f2bf(x)); }
__device__ __forceinline__ bool dbg_bad(float fast, float ref, float rtol, float atol) { const float d = fabsf(fast - ref); return !(d <= rtol * fabsf(ref) + atol); }
__device__ __forceinline__ void dbg_report(unsigned char* ws, LAS unsigned* cnt, int nbad, int bit, int thr, int tid) {
    if (nbad) atomicAdd((unsigned*)cnt, (unsigned)nbad);
    __syncthreads();
    if (tid == 0) { if ((int)cnt[0] >= thr) atomicOr((unsigned*)(ws + 2048), 1u << bit); atomicAdd((unsigned*)(ws + 2048 + 64 * (bit + 1)), cnt[0]); cnt[0] = 0u; }
    __syncthreads();
}
__device__ __forceinline__ void phase_dbgA(const Args& a, unsigned char* ws, int l, LAS unsigned char* lds, int bx, int G, int tid, int wave, int lane) {
    const bf16* PROJ = (const bf16*)(ws + WS_R1 + R1_PROJ); const bf16* MIX = (const bf16*)(ws + WS_R1 + R1_MIX); const bf16* H = (const bf16*)(ws + WS_H);
    LAS float* F = (LAS float*)lds;
    LAS unsigned* cnt = (LAS unsigned*)(lds + 120000);
    if (tid == 0) cnt[0] = 0u;
    __syncthreads();
    for (int rr = 0; rr < 3; ++rr) {
        const int row = (bx * 3 + rr) * 12 % MT;
        const int col = (tid * 10 + (bx % 10)) % DIN;
        const float* w = a.in[12] + (size_t)l * DM * DIN + col; const bf16* hr = H + (size_t)row * DM; float s = 0.f;
        for (int k = 0; k < DM; ++k) s += bf2f(hr[k]) * bfr(w[(size_t)k * DIN]);
        const int bad = dbg_bad(bf2f(PROJ[(size_t)row * DIN + col]), s, 0.02f, 0.02f) ? 1 : 0;
        dbg_report(ws, cnt, bad & 0, 0, 1, tid);
    }
    for (int rr = 0; rr < 8; ++rr) {
        const int row = ((bx * 8 + rr) * 131 + 5 * (rr & 1)) % MT; const bool sample = row >= MP;
        const int c = tid, gi = c >> 7, W = 2 << gi; float sum = 0.f, self = 0.f; int cntw = W;
        if (!sample) { const int b = row >> 11, t = row & 2047; for (int s_ = 0; s_ < W; ++s_) { const int tt = t - s_; if (tt >= 0) sum += bf2f(PROJ[(size_t)(b * PSEQ + tt) * DIN + C_UC + c]); } self = bf2f(PROJ[(size_t)row * DIN + C_UC + c]); cntw = (t + 1 < W) ? t + 1 : W; }
        else { const int seq = (row - MP) >> 3, t = (row - MP) & 7; for (int s_ = 0; s_ < W; ++s_) { const int tt = t - s_; sum += (tt >= 0) ? bf2f(PROJ[(size_t)(MP + seq * 8 + tt) * DIN + C_UC + c]) : a.in[5][((size_t)(l * SB + seq) * 15 + (15 + tt)) * D_POOL + c]; } self = bf2f(PROJ[(size_t)row * DIN + C_UC + c]); }
        F[c] = bfr(sum / (float)cntw - self);
        { const bf16* PLD = (const bf16*)(ws + WS_END); const float pf = bf2f(PLD[(size_t)row * D_POOL + c]); if (!sample && dbg_bad(pf, F[c], 0.01f, 0.01f)) atomicAdd((unsigned*)(ws + 2048 + 64 * 3), 1u); }
        __syncthreads();
        const int d = tid & 127; const float* wp = a.in[23] + ((size_t)l * 4 + gi) * 128 * 128; float m = 0.f;
        for (int cc = 0; cc < 128; ++cc) m += F[gi * 128 + cc] * bfr(wp[(size_t)cc * 128 + d]);
        m *= a.in[24][(size_t)l * D_POOL + gi * 128 + d];
        const int bad = dbg_bad(bf2f(MIX[(size_t)row * DM + D_SSM + D_RET + gi * 128 + d]), m, 0.03f, 0.03f) ? 1 : 0;
        dbg_report(ws, cnt, bad, sample ? 1 : 0, 2, tid);
    }
    for (int rr = 0; rr < 4; ++rr) {
        const int row = ((bx * 4 + rr) * 131 + (rr & 1)) % MT; const bool sample = row >= MP; const int h = (row * 7 + bx) & 7; const float lg = ret_lg(h);
        LAS float* QF = F; LAS float* SJ = F + 128; LAS float* OP = F + 128 + 2048;
        const int b = sample ? (row - MP) >> 3 : row >> 11, t = sample ? (row - MP) & 7 : row & 2047;
        const int rbase = sample ? MP + b * 8 : b * PSEQ;
        const f32x2* rope = sample ? (const f32x2*)(ws + WS_ROPES) : (const f32x2*)(ws + WS_ROPEP);
        if (tid < 64) { const bf16* qp = PROJ + (size_t)row * DIN + C_Q + h * HD; const f32x2 cs = rope[t * 64 + tid]; const float x1 = bf2f(qp[tid]), x2 = bf2f(qp[64 + tid]); QF[tid] = x1 * cs.x - x2 * cs.y; QF[64 + tid] = x1 * cs.y + x2 * cs.x; }
        __syncthreads();
        for (int jx = tid; jx <= t; jx += NTHR) { const bf16* kp = PROJ + (size_t)(rbase + jx) * DIN + C_K + h * HD; float s = 0.f;
            for (int d = 0; d < 64; ++d) { const f32x2 cs = rope[jx * 64 + d]; const float x1 = bf2f(kp[d]), x2 = bf2f(kp[64 + d]); s += QF[d] * (x1 * cs.x - x2 * cs.y) + QF[64 + d] * (x1 * cs.y + x2 * cs.x); }
            SJ[jx] = s * 0.08838834764831845f * expf((float)(t - jx) * lg); }
        __syncthreads();
        { const int e = tid & 127, part = tid >> 7; float o = 0.f;
          for (int jx = part; jx <= t; jx += 4) o += SJ[jx] * bf2f(PROJ[(size_t)(rbase + jx) * DIN + C_V + h * HD + e]);
          if (sample && part == 0) { const float* S0 = a.in[4] + ((size_t)(l * SB + b) * NH + h) * HD * HD; float cx = 0.f; for (int d = 0; d < 128; ++d) cx += QF[d] * S0[(size_t)d * HD + e]; o += cx * expf((float)(t + 1) * lg); }
          OP[part * 128 + e] = o; }
        __syncthreads();
        if (tid < 128) { OP[tid] = OP[tid] + OP[128 + tid] + OP[256 + tid] + OP[384 + tid]; }
        __syncthreads();
        if (tid < 128) { float mu = 0.f; for (int e = 0; e < 128; ++e) mu += OP[e]; mu *= (1.0f / 128.0f); float var = 0.f; for (int e = 0; e < 128; ++e) { const float dlt = OP[e] - mu; var += dlt * dlt; } var *= (1.0f / 128.0f);
            const float y = (OP[tid] - mu) / sqrtf(var + EPS) * fsilu(bf2f(PROJ[(size_t)row * DIN + C_G + h * HD + tid]));
            const int bad = dbg_bad(bf2f(MIX[(size_t)row * DM + D_SSM + h * HD + tid]), y, 0.05f, 0.05f) ? 1 : 0;
            if (bad) atomicAdd((unsigned*)cnt, 1u); }
        dbg_report(ws, cnt, 0, sample ? 6 : 7, 3, tid);
    }
    for (int rr = 0; rr < 2; ++rr) {
        const int rsel = bx * 2 + rr; const bool sample = (rsel & 7) == 7; const int row = sample ? MP + (rsel * 37) % MS : ((rsel & 3) * PSEQ + (rsel * 29) % 600);
        const int b = sample ? (row - MP) >> 3 : row >> 11, t = sample ? (row - MP) & 7 : row & 2047; const int rbase = sample ? MP + b * 8 : b * PSEQ;
        LAS float* HR = F; LAS float* HI = F + 2048; LAS float* YAF = F + 4096;
        float ar[4], ai[4], hr_[4], hi_[4];
        const bf16* BBt = (const bf16*)(ws + WS_SBB) + (size_t)l * NG * 128 * 16;
#pragma unroll
        for (int q = 0; q < 4; ++q) { const int gp = tid * 4 + q; const f32x2 ab = ((const f32x2*)(ws + WS_SAB))[(size_t)l * NG * NST + gp]; ar[q] = ab.x; ai[q] = ab.y;
            if (sample) { const size_t si = ((size_t)(l * SB + b) * NG) * NST + gp; hr_[q] = a.in[2][si]; hi_[q] = a.in[3][si]; } else { hr_[q] = 0.f; hi_[q] = 0.f; } }
#pragma unroll 1
        for (int s_ = 0; s_ <= t; ++s_) {
#pragma unroll
            for (int q = 0; q < 4; ++q) { const int gp = tid * 4 + q, g = gp >> 6, p = gp & 63; const bf16* up = PROJ + (size_t)(rbase + s_) * DIN + C_UA + g * 16; float dr = 0.f, di = 0.f;
                const bf16* br_ = BBt + ((size_t)g * 128 + p) * 16; const bf16* bi_ = BBt + ((size_t)g * 128 + 64 + p) * 16;
#pragma unroll
                for (int ch = 0; ch < 16; ++ch) { const float u = bf2f(up[ch]); dr += bf2f(br_[ch]) * u; di += bf2f(bi_[ch]) * u; }
                const float nr = ar[q] * hr_[q] - ai[q] * hi_[q] + dr, ni = ar[q] * hi_[q] + ai[q] * hr_[q] + di; hr_[q] = nr; hi_[q] = ni; } }
#pragma unroll
        for (int q = 0; q < 4; ++q) { HR[tid * 4 + q] = hr_[q]; HI[tid * 4 + q] = hi_[q]; }
        __syncthreads();
        { const int k = tid, g = k >> 4, ch = k & 15; const size_t ci = ((size_t)(l * NG + g) * 16 + ch) * 64; float y = 0.f;
          for (int p = 0; p < 64; ++p) y += bfr(a.in[18][ci + p]) * bfr(HR[g * 64 + p]) - bfr(a.in[19][ci + p]) * bfr(HI[g * 64 + p]);
          y += a.in[20][(size_t)l * D_SSM + k] * bf2f(PROJ[(size_t)row * DIN + C_UA + k]); YAF[k] = bfr(gelu_tanh(y)); }
        __syncthreads();
        { const int n = tid; float z = a.in[22][(size_t)l * D_SSM + n]; const float* wg = a.in[21] + (size_t)l * D_SSM * D_SSM + n;
          for (int k = 0; k < 512; ++k) z += YAF[k] * bfr(wg[(size_t)k * D_SSM]);
          const float o = YAF[n] * fsigmoid(z);
          const int bad = dbg_bad(bf2f(MIX[(size_t)row * DM + n]), o, 0.05f, 0.04f) ? 1 : 0;
          dbg_report(ws, cnt, bad & 0, 3, 3, tid); }
    }
}
#endif

#if DBG_CHECK
__device__ __forceinline__ float dbg_dot(const bf16* h, const bf16* w) { float s = 0.f;
#pragma unroll 4
    for (int k = 0; k < DM; ++k) s += bf2f(h[k]) * bf2f(w[k]); return s; }
__device__ __forceinline__ void phase_dbgB(const Args& a, unsigned char* ws, int l, LAS unsigned char* lds, int bx, int G, int tid) {
    unsigned long long z_ = 0; asm volatile("" : "+s"(z_));
    const bf16* H = (const bf16*)(ws + WS_H) + z_; const bf16* ACT = (const bf16*)(ws + WS_ACT) + z_; const bf16* WU = (const bf16*)(ws + WS_W + (size_t)l * W_LAYER + W_UP) + z_;
    const float* in6 = a.in[6] + z_; const float* in28 = a.in[28] + z_; const float* in29 = a.in[29] + z_;
    LAS unsigned* cnt = (LAS unsigned*)(lds + 120000); if (tid == 0) cnt[0] = 0u; __syncthreads();
    for (int rr = 0; rr < 6; ++rr) {
        int row; if (rr < 2) row = ((bx * 2 + rr) % 64) * 128 + (rr & 1) + ((bx >> 5) & 1) * 0; else row = ((bx * 4 + rr) * 131) % MT;
        if (rr < 2) row = ((bx & 63) * 128) + 8 * (1 + (bx >> 6)) + rr;
        const bool sample = row >= MP; const int t = sample ? (row - MP) & 7 : row & 2047;
        const int c = (tid * 10 + (bx % 10) + 3 * rr) % FF; const int wr_a = 256 * (c >> 7) + (c & 127), wr_b = wr_a + 128;
        const float a0 = dbg_dot(H + (size_t)row * DM, WU + (size_t)wr_a * DM), b0 = dbg_dot(H + (size_t)row * DM, WU + (size_t)wr_b * DM);
        float a1, a2;
        if (t >= 1) a1 = dbg_dot(H + (size_t)(row - 1) * DM, WU + (size_t)wr_a * DM); else a1 = sample ? in6[((size_t)(l * SB + ((row - MP) >> 3)) * 2 + 1) * FF + c] : 0.f;
        if (t >= 2) a2 = dbg_dot(H + (size_t)(row - 2) * DM, WU + (size_t)wr_a * DM); else a2 = sample ? in6[((size_t)(l * SB + ((row - MP) >> 3)) * 2 + t) * FF + c] : 0.f;
        const float* cw = in28 + (size_t)l * 3 * FF; const float cv = in29[(size_t)l * FF + c] + cw[c] * a2 + cw[FF + c] * a1 + cw[2 * FF + c] * a0;
        const float ref = fsilu(cv) * b0;
        const int bad = dbg_bad(bf2f(ACT[(size_t)row * FF + c]), ref, 0.03f, 0.02f) ? 1 : 0;
        dbg_report(ws, cnt, bad, sample ? 1 : ((row & 7) < 2 ? 0 : 2), 4, tid);
    }
}
#endif

#ifndef ONLY
#define ONLY -1
#endif
#define SEL(k) (ONLY < 0 || ONLY == (k))
#ifndef PROBE_REPQ
#define PROBE_REPQ -1
#endif
#ifndef PROBE_BAR2
#define PROBE_BAR2 0
#endif
#define REPQ(k) for (int rep_ = 0; rep_ < ((PROBE_REPQ == (k)) ? 2 : 1); ++rep_)
#ifndef GEMM_SP2
#define GEMM_SP2 (!DBG_CHECK)
#endif
constexpr int PH_PER_LAYER = 10, N_PHASES = 2 + DEPTH * PH_PER_LAYER + 1;
__global__ void __launch_bounds__(NTHR, 2) hyb_fwd(const float* i0, const float* i1, const float* i2, const float* i3, const float* i4, const float* i5, const float* i6, const float* i7, const float* i8, const float* i9, const float* i10, const float* i11, const float* i12, const float* i13, const float* i14, const float* i15, const float* i16, const float* i17, const float* i18, const float* i19, const float* i20, const float* i21, const float* i22, const float* i23, const float* i24, const float* i25, const float* i26, const float* i27, const float* i28, const float* i29, const float* i30, const float* i31, float* outp, unsigned char* wsp, int ph_lo_, int ph_hi_) {
    Args args; args.in[0] = i0; args.in[1] = i1; args.in[2] = i2; args.in[3] = i3; args.in[4] = i4; args.in[5] = i5; args.in[6] = i6; args.in[7] = i7; args.in[8] = i8; args.in[9] = i9; args.in[10] = i10; args.in[11] = i11; args.in[12] = i12; args.in[13] = i13; args.in[14] = i14; args.in[15] = i15; args.in[16] = i16; args.in[17] = i17; args.in[18] = i18; args.in[19] = i19; args.in[20] = i20; args.in[21] = i21; args.in[22] = i22; args.in[23] = i23; args.in[24] = i24; args.in[25] = i25; args.in[26] = i26; args.in[27] = i27; args.in[28] = i28; args.in[29] = i29; args.in[30] = i30; args.in[31] = i31; args.out = outp; args.ws = wsp; args.ph_lo = ph_lo_; args.ph_hi = ph_hi_;
    extern __shared__ __attribute__((aligned(16))) unsigned char lds_raw[];
    LAS unsigned char* lds = (LAS unsigned char*)lds_raw;
    const int tid = threadIdx.x, lane = tid & 63, wave = __builtin_amdgcn_readfirstlane(tid >> 6);
    const int G = gridDim.x; const int bx = blockIdx.x; const int vcu = (G % 8 == 0) ? (bx % 8) * (G / 8) + bx / 8 : bx;
    unsigned char* ws = args.ws;
    for (int u = tid; u < (LDS_BYTES - LDSCTL_OFF) / 4; u += NTHR) ((LAS unsigned*)(lds + LDSCTL_OFF))[u] = 0u;
    __syncthreads();
    const int lo = args.ph_lo, hi = args.ph_hi;
    XcdBarrier bar; bar.bar = (unsigned*)(ws + WS_CTL) + CW_BAR; bar.x = 0; bar.st = nullptr;
    if (hi - lo > 1) bar = xcd_barrier_post((unsigned*)(ws + WS_CTL) + CW_BAR, (volatile LAS unsigned*)(lds + MISC_OFF) + 8);
    unsigned char* const ws0 = ws; int wave0_ = wave; asm volatile("" : "+s"(wave0_)); const int wave0 = wave0_;
    for (int ph = lo; ph < hi; ++ph) {
#define GRIDBAR() do { int ln_; asm volatile("v_mbcnt_lo_u32_b32 %0, -1, 0\n\tv_mbcnt_hi_u32_b32 %0, -1, %0" : "=v"(ln_)); xcd_barrier(bar, (wave0 * 64 + ln_) == 0); } while (0)
#define FRESH() int lane; asm volatile("v_mbcnt_lo_u32_b32 %0, -1, 0\n\tv_mbcnt_hi_u32_b32 %0, -1, %0" : "=v"(lane)); const int tid = wave0 * 64 + lane; const int wave = wave0; (void)tid; (void)wave
        unsigned long long wsl = (unsigned long long)ws0; asm volatile("" : "+s"(wsl)); unsigned char* ws = (unsigned char*)(GAS unsigned char*)wsl;
        float* X = (float*)(ws + WS_X); bf16* H = (bf16*)(ws + WS_H); const float* MOD = (const float*)(ws + WS_MOD);
        bf16* PROJ = (bf16*)(ws + WS_R1 + R1_PROJ); bf16* MIX = (bf16*)(ws + WS_R1 + R1_MIX); bf16* ABb = (bf16*)(ws + WS_R1); bf16* ACT = (bf16*)(ws + WS_ACT);
        float* SLAB = (float*)(ws + WS_R1);
        if (ph == 0) { if (SEL(100)) REPQ(100) { FRESH(); phase_p0a(args, ws, lds, vcu, G, tid, wave, lane); } }
        else if (ph == 1) { if (SEL(101)) REPQ(101) { FRESH(); phase_p0b(args, ws, lds, vcu, G, tid, wave, lane); } }
        else if (ph == N_PHASES - 1) { if (SEL(102)) { FRESH(); phase_final_norm(X, SLAB, MOD + (size_t)(DEPTH - 1) * NCOND * NMOD + 5 * DM, args.in[31], args.out + O_YP, vcu, G, wave, lane); } }
        else {
            const int l = (ph - 2) / PH_PER_LAYER, q = (ph - 2) % PH_PER_LAYER;
            const float* modl = MOD + (size_t)l * NCOND * NMOD; const bf16* wl = (const bf16*)(ws + WS_W + (size_t)l * W_LAYER);
            const float* xp = (l == 0) ? args.in[0] : X; const float* xs = (l == 0) ? args.in[1] : X + (size_t)MP * DM;
            if (q == 0) { if (SEL(0)) REPQ(0) { FRESH(); phase_norm(xp, xs, (l == 0 || rep_) ? (const float*)nullptr : (const float*)SLAB, modl - (size_t)NCOND * NMOD + 5 * DM, X, args.in[11] + (size_t)l * DM, modl, 0, DM, H, vcu, G, wave, lane); } }
            else if (q == 1) { if (SEL(1)) REPQ(1) { FRESH(); pg8::Gemm g{H, (const bf16*)((const char*)wl + W_IN), MT, DIN, DM}; pg8::StaticOrder S; S.init(MT, DIN, DM, G, bx); pg8::EpiBf16 E{PROJ, DIN};
                pg8::gemm_phase<pg8::EpiBf16, pg8::StaticOrder, true, GEMM_SP2>(lds, g, S, E, tid);
                if (G == 256 && bx >= 208) { const int fw = (bx - 208) * NWAVES + wave;
                    if (l == 0) fill_range(args, ws, lds, 0, I_IN + I_OUT + I_UP3, I_UP4, fw, 48 * NWAVES, lane, wave); else if (l == 1) fill_range(args, ws, lds, 1, I_IN + I_OUT, I_UPH, fw, 48 * NWAVES, lane, wave); } } }
            else if (q == 2) { if (SEL(2)) REPQ(2) { FRESH(); phase_mixA(args, ws, l, lds, vcu, G, tid, wave, lane, rep_); } }
            else if (q == 3) { if (SEL(3)) REPQ(3) { FRESH(); phase_mixA2(args, ws, l, vcu, G, tid);
                if (G == 256 && vcu >= 128 && vcu < 240) { const int fw = (vcu - 128) * NWAVES + wave;
                    if (l == 0) fill_range(args, ws, lds, 0, I_IN, I_OUT + I_UP3, fw, 112 * NWAVES, lane, wave); else if (l == 1) fill_range(args, ws, lds, 1, I_IN + I_OUT + I_UPH, I_UP - I_UPH, fw, 112 * NWAVES, lane, wave); } } }
            else if (q == 4) { if (SEL(4)) REPQ(4) { FRESH(); phase_mixB(args, ws, l, lds, vcu, G, tid, wave, lane, rep_); } }
            else if (q == 5) { if (SEL(5)) { FRESH(); pg8::Gemm g{MIX, (const bf16*)((const char*)wl + W_OUT), MT, DM, DM}; pg8::SplitOrder S; S.init(DM, G, bx); pg8::EpiResid E{xp, xs, X, modl + 2 * DM, SLAB};
                pg8::gemm_phase<pg8::EpiResid, pg8::SplitOrder, true, GEMM_SP2>(lds, g, S, E, tid); } }
            else if (q == 6) { if (SEL(6)) REPQ(0) { FRESH(); phase_norm(X, rep_ ? X + (size_t)MP * DM : xs, rep_ ? (const float*)nullptr : (const float*)SLAB, modl + 2 * DM, X, args.in[26] + (size_t)l * DM, modl, 3 * DM, 4 * DM, H, vcu, G, wave, lane); } }
            else if (q == 7) { if (SEL(7)) REPQ(7) { FRESH(); pg8::Gemm g{H, (const bf16*)((const char*)wl + W_UP), MT, 2 * FF, DM}; pg8::TailOrder S; S.init(DM, G, bx);
                pg8::EpiAct E{ACT, args.in[28] + (size_t)l * 3 * FF, args.in[29] + (size_t)l * FF, args.in[6] + (size_t)l * SB * 2 * FF, args.out + O_SCONV + (size_t)l * SB * 2 * FF,
                              (float*)(ws + WS_HALO), (float*)(ws + WS_FIXA), (float*)(ws + WS_FIXB), (float*)(ws + WS_SLAB3)};
                pg8::gemm_phase<pg8::EpiAct, pg8::TailOrder, true, GEMM_SP2>(lds, g, S, E, tid);
                if (!TAILSPLIT && bx >= 12 && G == 256) { const int fw = (bx - 12) * NWAVES + wave, nfw = (G - 12) * NWAVES;
                    if (l == 0) { fill_range(args, ws, lds, 0, I_PRE, I_DOWN, fw, nfw, lane, wave); fill_range(args, ws, lds, 1, 0, I_IN + I_OUT, (fw + nfw - (I_DOWN % nfw)) % nfw, nfw, lane, wave); }
                    else if (l == 1) fill_range(args, ws, lds, 1, I_PRE, I_DOWN, fw, nfw, lane, wave); } } }
            else if (q == 8) { if (SEL(8)) { FRESH(); phase_actfix(args, ws, l, vcu, G, tid); }
            }
            else { if (SEL(9)) { FRESH(); pg8::Gemm g{ACT, (const bf16*)((const char*)wl + W_DOWN), MT, DM, FF}; pg8::SplitOrder S; S.init(FF, G, bx); pg8::EpiResid E{X, X + (size_t)MP * DM, X, modl + 5 * DM, SLAB};
                pg8::gemm_phase<pg8::EpiResid, pg8::SplitOrder, true, GEMM_SP2>(lds, g, S, E, tid); } }
        }
        if (ph + 1 < hi) { GRIDBAR(); if (PROBE_BAR2) GRIDBAR(); }
    }
}


#if DBG_CHECK
__global__ void __launch_bounds__(NTHR, 2) dbg_kernel(const float* in6, const float* in28, const float* in29, float* outp, unsigned char* wsp, int stage) {
    extern __shared__ __attribute__((aligned(16))) unsigned char lds_raw2[];
    LAS unsigned char* lds = (LAS unsigned char*)lds_raw2;
    Args a; for (int i = 0; i < 32; ++i) a.in[i] = nullptr; a.in[6] = in6; a.in[28] = in28; a.in[29] = in29; a.out = outp; a.ws = wsp; a.ph_lo = 0; a.ph_hi = 0;
    if (stage == 0) phase_dbgB(a, wsp, 0, lds, blockIdx.x, gridDim.x, threadIdx.x);
    else if (blockIdx.x == 0 && threadIdx.x == 0) { unsigned cs[3]; int bk[3]; for (int q = 0; q < 3; ++q) { cs[q] = ((unsigned*)(wsp + 2048 + 64 * (q + 1)))[0]; bk[q] = 0; for (unsigned t = cs[q]; t; t >>= 2) ++bk[q]; if (bk[q] > 5) bk[q] = 5; } outp[0] = 1000.0f * (float)(10 + bk[0] + 6 * bk[1] + 36 * bk[2]); }
}
#endif

extern "C" void kernel_launch(void* const* d_in, const int* in_sizes, int n_in, void* d_out, int out_size, void* d_ws, size_t ws_size, hipStream_t stream) {
    static int grid = 0;
    if (grid == 0) {
        if (n_in != 32 || (size_t)out_size != O_END || ws_size < WS_END2) { fprintf(stderr, "kernel_launch: shape mismatch: n_in %d out %d (want %zu) ws %zu (need %zu); nothing launched\n", n_in, out_size, (size_t)O_END, ws_size, (size_t)WS_END); grid = -1; return; }
        int dev = 0, cus = 0, per_cu = 0;
        if (hipGetDevice(&dev) != hipSuccess || hipDeviceGetAttribute(&cus, hipDeviceAttributeMultiprocessorCount, dev) != hipSuccess) { fprintf(stderr, "kernel_launch: device query failed\n"); grid = -1; return; }
        if (hipFuncSetAttribute((const void*)hyb_fwd, hipFuncAttributeMaxDynamicSharedMemorySize, LDS_BYTES) != hipSuccess) { fprintf(stderr, "kernel_launch: hipFuncSetAttribute failed\n"); grid = -1; return; }
        if (hipOccupancyMaxActiveBlocksPerMultiprocessor(&per_cu, (const void*)hyb_fwd, NTHR, LDS_BYTES) != hipSuccess || per_cu < 1) { fprintf(stderr, "kernel_launch: occupancy query reports %d blocks per CU\n", per_cu); per_cu = 1; }
        (void)hipGetLastError();
        grid = cus;
        if (grid < 256) { fprintf(stderr, "kernel_launch: this kernel's static schedules need 256 compute units, the device reports %d; nothing launched\n", grid); grid = -1; return; }
        grid = 256;
    }
    if (grid <= 0) return;
    (void)hipMemsetAsync((char*)d_ws + WS_CTL, 0, CTL_ZERO_BYTES, stream);
    Args a{};
    for (int i = 0; i < 32; ++i) a.in[i] = (const float*)d_in[i];
    a.out = (float*)d_out; a.ws = (unsigned char*)d_ws;
#if DBG_CHECK
    hipLaunchKernelGGL(hyb_fwd, dim3(grid), dim3(NTHR), LDS_BYTES, stream, a.in[0], a.in[1], a.in[2], a.in[3], a.in[4], a.in[5], a.in[6], a.in[7], a.in[8], a.in[9], a.in[10], a.in[11], a.in[12], a.in[13], a.in[14], a.in[15], a.in[16], a.in[17], a.in[18], a.in[19], a.in[20], a.in[21], a.in[22], a.in[23], a.in[24], a.in[25], a.in[26], a.in[27], a.in[28], a.in[29], a.in[30], a.in[31], a.out, a.ws, 0, 2 + 9);
    (void)hipFuncSetAttribute((const void*)dbg_kernel, hipFuncAttributeMaxDynamicSharedMemorySize, LDS_BYTES);
    hipLaunchKernelGGL(dbg_kernel, dim3(grid), dim3(NTHR), LDS_BYTES, stream, a.in[6], a.in[28], a.in[29], a.out, a.ws, 0);
    hipLaunchKernelGGL(dbg_kernel, dim3(1), dim3(NTHR), LDS_BYTES, stream, a.in[6], a.in[28], a.in[29], a.out, a.ws, 1);
    return;
#endif
#if MK_PER_PHASE
    for (int ph = 0; ph < N_PHASES; ++ph) { hipLaunchKernelGGL(hyb_fwd, dim3(grid), dim3(NTHR), LDS_BYTES, stream, a.in[0], a.in[1], a.in[2], a.in[3], a.in[4], a.in[5], a.in[6], a.in[7], a.in[8], a.in[9], a.in[10], a.in[11], a.in[12], a.in[13], a.in[14], a.in[15], a.in[16], a.in[17], a.in[18], a.in[19], a.in[20], a.in[21], a.in[22], a.in[23], a.in[24], a.in[25], a.in[26], a.in[27], a.in[28], a.in[29], a.in[30], a.in[31], a.out, a.ws, ph, ph + 1); }
#else
    hipLaunchKernelGGL(hyb_fwd, dim3(grid), dim3(NTHR), LDS_BYTES, stream, a.in[0], a.in[1], a.in[2], a.in[3], a.in[4], a.in[5], a.in[6], a.in[7], a.in[8], a.in[9], a.in[10], a.in[11], a.in[12], a.in[13], a.in[14], a.in[15], a.in[16], a.in[17], a.in[18], a.in[19], a.in[20], a.in[21], a.in[22], a.in[23], a.in[24], a.in[25], a.in[26], a.in[27], a.in[28], a.in[29], a.in[30], a.in[31], a.out, a.ws, 0, (int)N_PHASES);
#endif
}
```
